# Optimizing an MI355X kernel written in HIP

```python
import math
import jax, jax.numpy as jnp
from jax import lax
import numpy as np

D_MODEL = 1024
BATCH = 8
SEQ = 2048
DEPTH = 4

CTX_LEN = 256
GRID_W = 64
DIFF_HEADS = 4
DIFF_HEAD_DIM = 64
DIFF_WIDTH = DIFF_HEADS * 2 * DIFF_HEAD_DIM
POOL_WINDOWS = (2, 4, 8, 16)
POOL_GROUPS = 4
POOL_WIDTH = 512
POOL_GROUP_DIM = POOL_WIDTH // POOL_GROUPS
NAT_HEADS = 8
NAT_HEAD_DIM = 64
NAT_WIDTH = NAT_HEADS * NAT_HEAD_DIM
WIN_ROWS = 8
WIN_COLS = 16
N_BRANCHES = 3
IN_COLS = 3 * DIFF_WIDTH + POOL_WIDTH + 3 * NAT_WIDTH + N_BRANCHES * D_MODEL
D_FF = 4 * D_MODEL
Q_BLOCK = 128
ROPE_BASE = 10000.0
NORM_EPS = 1e-6

kernel_name = "hybrid_gated_diffattn_pool_natten_block"


def rms_norm(x, g):
    xf = x.astype(jnp.float32)
    y = xf * lax.rsqrt(jnp.mean(xf * xf, axis=-1, keepdims=True) + NORM_EPS)
    return (y * g.astype(jnp.float32)).astype(x.dtype)


def modulate(h, shift, scale):
    return h * (1 + scale) + shift


def adaln(cond, w, b):
    m = jax.nn.silu(cond) @ w + b
    m = m.reshape(m.shape[:-1] + (1, 6, D_MODEL))
    return tuple(m[..., i, :] for i in range(6))


def split_in(z):
    sizes = (DIFF_WIDTH,) * 3 + (POOL_WIDTH,) + (NAT_WIDTH,) * 3
    idx = [int(v) for v in np.cumsum(sizes)]
    return jnp.split(z, idx, axis=-1)


def axial_rope(x):
    L, dh = x.shape[1], x.shape[-1]
    half = dh // 2
    nf = half // 2
    pos = jnp.arange(L)
    row = (pos // GRID_W).astype(jnp.float32)
    col = (pos % GRID_W).astype(jnp.float32)
    inv = ROPE_BASE ** (-jnp.arange(nf, dtype=jnp.float32) / nf)

    def rot(u, p):
        ang = p[:, None] * inv
        cos = jnp.cos(ang)[None, :, None, None, :].astype(x.dtype)
        sin = jnp.sin(ang)[None, :, None, None, :].astype(x.dtype)
        u1, u2 = u[..., :nf], u[..., nf:]
        return jnp.concatenate([u1 * cos - u2 * sin, u1 * sin + u2 * cos], axis=-1)

    return jnp.concatenate([rot(x[..., :half], row), rot(x[..., half:], col)], axis=-1)


def diff_attention(q, k, v, lam):
    B, Lq, H, _, dh = q.shape
    nb = Lq // Q_BLOCK
    qb = q.reshape(B, nb, Q_BLOCK, H, 2, dh).swapaxes(0, 1)
    sc = dh ** -0.5

    def block(qq):
        s = jnp.einsum('bqhmd,bkhmd->bhmqk', qq, k).astype(jnp.float32) * sc
        p = jax.nn.softmax(s, axis=-1)
        a = (p[:, :, 0] - lam * p[:, :, 1]).astype(v.dtype)
        return jnp.einsum('bhqk,bkhe->bqhe', a, v)

    o = lax.map(block, qb)
    return o.swapaxes(0, 1).reshape(B, Lq, H, v.shape[-1])


def diff_head_out(o, g_subln, lam_init):
    B, L = o.shape[0], o.shape[1]
    return (rms_norm(o, g_subln) * (1.0 - lam_init)).reshape(B, L, DIFF_WIDTH)


def dense_attention(q, k, v):
    s = jnp.einsum('bqhd,bkhd->bhqk', q, k).astype(jnp.float32) * (q.shape[-1] ** -0.5)
    p = jax.nn.softmax(s, axis=-1).astype(v.dtype)
    return jnp.einsum('bhqk,bkhd->bqhd', p, v)


def neighbourhood_attention(q, k, v, kc, vc, rpb):
    B, L, H, d = q.shape
    rows = L // GRID_W
    kr = min(WIN_ROWS, rows)
    sc = d ** -0.5
    qg = q.reshape(B, rows, GRID_W, H, d)
    kg = k.reshape(B, rows, GRID_W, H, d)
    vg = v.reshape(B, rows, GRID_W, H, d)
    r = jnp.arange(rows)
    row_idx = jnp.clip(r - kr // 2, 0, rows - kr)[:, None] + jnp.arange(kr)
    cq = jnp.arange(GRID_W)
    col_idx = jnp.clip(cq - WIN_COLS // 2, 0, GRID_W - WIN_COLS)[:, None] + jnp.arange(WIN_COLS)
    d_row = row_idx - r[:, None] + (WIN_ROWS - 1)
    d_col = col_idx - cq[:, None] + (WIN_COLS - 1)
    rpb_c = rpb[:, :, d_col]
    n_loc = kr * WIN_COLS

    def one_row(args):
        q_r, ridx, dr = args
        k_win = kg[:, ridx][:, :, col_idx]
        v_win = vg[:, ridx][:, :, col_idx]
        bias = rpb_c[:, dr].transpose(0, 2, 1, 3).astype(jnp.float32)
        s_loc = jnp.einsum('bwhd,brwkhd->bhwrk', q_r, k_win).astype(jnp.float32) * sc + bias
        s_ctx = jnp.einsum('bwhd,bchd->bhwc', q_r, kc).astype(jnp.float32) * sc
        s = jnp.concatenate([s_loc.reshape(B, H, GRID_W, n_loc), s_ctx], axis=-1)
        p = jax.nn.softmax(s, axis=-1).astype(v.dtype)
        p_loc = p[..., :n_loc].reshape(B, H, GRID_W, kr, WIN_COLS)
        p_ctx = p[..., n_loc:]
        return (jnp.einsum('bhwrk,brwkhd->bwhd', p_loc, v_win)
                + jnp.einsum('bhwc,bchd->bwhd', p_ctx, vc))

    o = lax.map(one_row, (qg.swapaxes(0, 1), row_idx, d_row))
    return o.swapaxes(0, 1).reshape(B, L, H, d)


def multiscale_pool(u, group_w, chan_scale):
    B, L, _ = u.shape
    uf = u.astype(jnp.float32)
    csum = jnp.concatenate([jnp.zeros((B, 1, POOL_WIDTH), jnp.float32), jnp.cumsum(uf, axis=1)], axis=1)
    t = jnp.arange(L)
    parts = []
    for gi, w in enumerate(POOL_WINDOWS):
        sl = slice(gi * POOL_GROUP_DIM, (gi + 1) * POOL_GROUP_DIM)
        lo = jnp.clip(t - w // 2, 0, L)
        hi = jnp.clip(t + w // 2, 0, L)
        cnt = (hi - lo).astype(jnp.float32)[None, :, None]
        cg = csum[:, :, sl]
        parts.append((cg[:, hi] - cg[:, lo]) / cnt - uf[:, :, sl])
    p = jnp.concatenate(parts, axis=-1).astype(u.dtype).reshape(B, L, POOL_GROUPS, POOL_GROUP_DIM)
    y = jnp.einsum('blgc,gce->blge', p, group_w).reshape(B, L, POOL_WIDTH)
    return y * chan_scale


def merge_branches(o_a, o_b, o_c, gate_logits, w_branch, w_out):
    g = jax.nn.sigmoid(gate_logits.astype(jnp.float32)).astype(o_a.dtype)
    g = g.reshape(gate_logits.shape[:-1] + (N_BRANCHES, D_MODEL))
    merged = (g[..., 0, :] * (o_a @ w_branch[0])
              + g[..., 1, :] * (o_b @ w_branch[1])
              + g[..., 2, :] * (o_c @ w_branch[2]))
    return merged @ w_out


def sq_relu_mlp(h, w1, w2):
    return jnp.square(jax.nn.relu(h @ w1)) @ w2


def setup_inputs(seed: int = 0) -> dict:
    key = jax.random.key(seed)
    ks = jax.random.split(key, 24)

    def nrm(k, shape, std):
        return jax.random.normal(k, shape, jnp.float32) * std

    dh = DIFF_HEAD_DIM
    return {
        "x": nrm(ks[0], (BATCH, SEQ, D_MODEL), 1.0),
        "c": nrm(ks[1], (BATCH, D_MODEL), 1.0),
        "ctx": nrm(ks[2], (BATCH, CTX_LEN, D_MODEL), 1.0),
        "c_ctx": nrm(ks[3], (D_MODEL,), 1.0),
        "w_ada": nrm(ks[4], (DEPTH, D_MODEL, 6 * D_MODEL), 0.5 * D_MODEL ** -0.5),
        "b_ada": nrm(ks[5], (DEPTH, 6 * D_MODEL), 0.01),
        "g_mix": 1.0 + nrm(ks[6], (DEPTH, D_MODEL), 0.05),
        "g_mlp": 1.0 + nrm(ks[7], (DEPTH, D_MODEL), 0.05),
        "w_in": nrm(ks[8], (DEPTH, D_MODEL, IN_COLS), D_MODEL ** -0.5),
        "lambda_q1": nrm(ks[9], (DEPTH, dh), 0.1),
        "lambda_k1": nrm(ks[10], (DEPTH, dh), 0.1),
        "lambda_q2": nrm(ks[11], (DEPTH, dh), 0.1),
        "lambda_k2": nrm(ks[12], (DEPTH, dh), 0.1),
        "g_subln": 1.0 + nrm(ks[13], (DEPTH, 2 * dh), 0.05),
        "pool_w": nrm(ks[14], (DEPTH, POOL_GROUPS, POOL_GROUP_DIM, POOL_GROUP_DIM), POOL_GROUP_DIM ** -0.5),
        "pool_scale": 1.0 + nrm(ks[15], (DEPTH, POOL_WIDTH), 0.1),
        "nat_rpb": nrm(ks[16], (DEPTH, NAT_HEADS, 2 * WIN_ROWS - 1, 2 * WIN_COLS - 1), 0.1),
        "w_branch": nrm(ks[17], (DEPTH, N_BRANCHES, DIFF_WIDTH, D_MODEL), DIFF_WIDTH ** -0.5),
        "w_out": nrm(ks[18], (DEPTH, D_MODEL, D_MODEL), D_MODEL ** -0.5),
        "w_mlp1": nrm(ks[19], (DEPTH, D_MODEL, D_FF), D_MODEL ** -0.5),
        "w_mlp2": nrm(ks[20], (DEPTH, D_FF, D_MODEL), D_FF ** -0.5),
        "g_final": 1.0 + nrm(ks[21], (D_MODEL,), 0.05),
    }


def reference(x, c, ctx, c_ctx, w_ada, b_ada, g_mix, g_mlp, w_in, lambda_q1, lambda_k1, lambda_q2, lambda_k2,
              g_subln, pool_w, pool_scale, nat_rpb, w_branch, w_out, w_mlp1, w_mlp2, g_final):
    B, L, _ = x.shape
    C = ctx.shape[1]
    H, dh = DIFF_HEADS, DIFF_HEAD_DIM
    xc = ctx
    for l in range(DEPTH):
        last = l == DEPTH - 1
        lam_init = 0.8 - 0.6 * math.exp(-0.3 * l)
        f32 = jnp.float32
        lam = (jnp.exp(jnp.sum(lambda_q1[l].astype(f32) * lambda_k1[l].astype(f32)))
               - jnp.exp(jnp.sum(lambda_q2[l].astype(f32) * lambda_k2[l].astype(f32))) + lam_init)
        sh1, sc1, ga1, sh2, sc2, ga2 = adaln(c, w_ada[l], b_ada[l])
        csh1, csc1, cga1, csh2, csc2, cga2 = adaln(c_ctx, w_ada[l], b_ada[l])

        h = modulate(rms_norm(x, g_mix[l]), sh1, sc1)
        hc = modulate(rms_norm(xc, g_mix[l]), csh1, csc1)
        qa, ka, va, pu, qn, kn, vn, gl = split_in(h @ w_in[l])
        qac, kac, vac, puc, qnc, knc, vnc, glc = split_in(hc @ w_in[l])

        qa = axial_rope(qa.reshape(B, L, H, 2, dh))
        ka = axial_rope(ka.reshape(B, L, H, 2, dh))
        va = va.reshape(B, L, H, 2 * dh)
        kac = kac.reshape(B, C, H, 2, dh)
        vac = vac.reshape(B, C, H, 2 * dh)
        o_a = diff_attention(qa, jnp.concatenate([kac, ka], axis=1), jnp.concatenate([vac, va], axis=1), lam)
        o_a = diff_head_out(o_a, g_subln[l], lam_init)

        o_b = multiscale_pool(pu, pool_w[l], pool_scale[l])

        knc = knc.reshape(B, C, NAT_HEADS, NAT_HEAD_DIM)
        vnc = vnc.reshape(B, C, NAT_HEADS, NAT_HEAD_DIM)
        o_c = neighbourhood_attention(qn.reshape(B, L, NAT_HEADS, NAT_HEAD_DIM),
                                      kn.reshape(B, L, NAT_HEADS, NAT_HEAD_DIM),
                                      vn.reshape(B, L, NAT_HEADS, NAT_HEAD_DIM),
                                      knc, vnc, nat_rpb[l]).reshape(B, L, NAT_WIDTH)

        x = x + ga1 * merge_branches(o_a, o_b, o_c, gl, w_branch[l], w_out[l])

        if not last:
            o_ac = diff_head_out(diff_attention(qac.reshape(B, C, H, 2, dh), kac, vac, lam), g_subln[l], lam_init)
            o_bc = multiscale_pool(puc, pool_w[l], pool_scale[l])
            o_cc = dense_attention(qnc.reshape(B, C, NAT_HEADS, NAT_HEAD_DIM), knc, vnc).reshape(B, C, NAT_WIDTH)
            xc = xc + cga1 * merge_branches(o_ac, o_bc, o_cc, glc, w_branch[l], w_out[l])

        h = modulate(rms_norm(x, g_mlp[l]), sh2, sc2)
        x = x + ga2 * sq_relu_mlp(h, w_mlp1[l], w_mlp2[l])
        if not last:
            hc = modulate(rms_norm(xc, g_mlp[l]), csh2, csc2)
            xc = xc + cga2 * sq_relu_mlp(hc, w_mlp1[l], w_mlp2[l])

    return rms_norm(x, g_final)
```

```cpp
#include <hip/hip_runtime.h>
#include <hip/hip_cooperative_groups.h>
#include <cstdio>
#include <cstdint>
namespace cg = cooperative_groups;
__device__ __forceinline__ int fresh_tid() { int t = (int)threadIdx.x; asm volatile("" : "+v"(t)); return t; }
namespace pg8 {
#define PG8_LAS __attribute__((address_space(3)))
typedef unsigned short bf16_t;
typedef short bf16x8 __attribute__((ext_vector_type(8)));
typedef float f32x4 __attribute__((ext_vector_type(4)));
typedef unsigned u32x4 __attribute__((ext_vector_type(4)));
constexpr int BM = 256, BK = 64, HALF = 128, HTB = HALF * BK * 2  , STAGE_BYTES = 8 * HTB, NXCD = 8, WGM = 8;

__host__ __device__ __forceinline__ int lds_byte(int r, int c) { const int st = (r >> 4) * 2 + (c >> 5), rr = r & 15, cc = c & 31, ob = rr * 64 + cc * 2; return st * 1024 + (ob ^ (((ob >> 9) & 1) << 5)); }
__host__ __device__ __forceinline__ void stage_rc(int b, int& R, int& C) { const int st = b / 1024, sb = b % 1024, swz = sb ^ (((sb >> 9) & 1) << 5); R = (st >> 1) * 16 + swz / 64; C = (st & 1) * 32 + (swz % 64) / 2; }
__host__ __device__ __forceinline__ int perm32(int rho) { const int n = rho >> 4, i = rho & 15; return 8 * (i >> 2) + 4 * n + (i & 3); }

struct Unit { int pm, pn, koff, nt, ks; };
struct Gemm { const bf16_t* A; const bf16_t* Bt; int M, N, K; };

struct StaticOrder {
    int nM, nN, nwg, G, c, ntf;
    __host__ __device__ __forceinline__ void init(int M, int N, int G_, int c_, int K_) { nM = M / BM; nN = N / BM; nwg = nM * nN; G = G_; c = c_; ntf = K_ / BK; }
    __host__ __device__ __forceinline__ bool next(int i, Unit& u) const {
        const long L = (long)i * G + c; if (L >= nwg) return false;
        int wgid = (int)L; { const int q = nwg / NXCD, r = nwg % NXCD, xcd = wgid % NXCD, off = wgid / NXCD; wgid = (xcd < r ? xcd * (q + 1) : r * (q + 1) + (xcd - r) * q) + off; }
        const int nig = WGM * nN, gid = wgid / nig, fm = gid * WGM, gsz = (nM - fm) < WGM ? (nM - fm) : WGM;
        u.pm = fm + ((wgid % nig) % gsz); u.pn = (wgid % nig) / gsz; u.koff = 0; u.nt = ntf; u.ks = 0; return true;
    }
    __device__ __forceinline__ void a_ready(const Unit&) const {}
    __device__ __forceinline__ void done(const Unit&) const {}
};

template <class Epi, class Sched, bool ALIGN_EPI = false, bool SP2 = false>
__device__ __forceinline__ void gemm_phase(PG8_LAS unsigned char* lds, const Gemm g, const Sched& S, const Epi& E) {
    const int tid = fresh_tid(), wid = __builtin_amdgcn_readfirstlane(tid >> 6), lane = tid & 63, wr = wid >> 2, wc = wid & 3, fr = lane & 15, fq = lane >> 4;
    const int K = g.K;
    unsigned voffA[2], voffB[2];
#pragma unroll
    for (int i = 0; i < 2; ++i) { int R, C; stage_rc(tid * 16 + i * 8192, R, C); const int Rb = Epi::PERM ? ((R & ~31) + perm32(R & 31)) : R;
        voffA[i] = (unsigned)(R * K + C) * 2u; voffB[i] = (unsigned)(Rb * K + C) * 2u; }
    const size_t kstep = (size_t)(BK * 2);
    const size_t hstep = (size_t)HALF * K * 2;
    const size_t tstep = 2 * hstep;
    const unsigned ldsw = (unsigned)wid * 1024u;
    const int aoff = lds_byte(wr * 64 + fr, fq * 8), boff = lds_byte(wc * 32 + fr, fq * 8);
#define PG8_SA(b, h) (((b) * 2 + (h)) * HTB)
#define PG8_SB(b, h) ((4 + (b) * 2 + (h)) * HTB)
#define PG8_STAGE(bufoff, gbase, voff) do { _Pragma("unroll") for (int _i = 0; _i < 2; ++_i) \
        __builtin_amdgcn_global_load_lds((const unsigned*)((const char*)(gbase) + (voff)[_i]), (PG8_LAS unsigned*)(lds + (bufoff) + ldsw + _i * 8192), 16, 0, 0); } while (0)
#define PG8_LDA(dst, b, h) do { _Pragma("unroll") for (int m = 0; m < 4; ++m) _Pragma("unroll") for (int k = 0; k < 2; ++k) dst[m][k] = *(const PG8_LAS bf16x8*)(lds + PG8_SA(b, h) + aoff + m * 2048 + k * 1024); } while (0)
#define PG8_LDB(dst, b, h) do { _Pragma("unroll") for (int n = 0; n < 2; ++n) _Pragma("unroll") for (int k = 0; k < 2; ++k) dst[n][k] = *(const PG8_LAS bf16x8*)(lds + PG8_SB(b, h) + boff + n * 2048 + k * 1024); } while (0)
#define PG8_MMA(ai, bj, At, Bt) do { __builtin_amdgcn_s_setprio(1); _Pragma("unroll") for (int m = 0; m < 4; ++m) _Pragma("unroll") for (int n = 0; n < 2; ++n) _Pragma("unroll") for (int k = 0; k < 2; ++k) \
        acc[ai][bj][m][n] = __builtin_amdgcn_mfma_f32_16x16x32_bf16(Bt[n][k], At[m][k], acc[ai][bj][m][n], 0, 0, 0); __builtin_amdgcn_s_setprio(0); } while (0)
#define PG8_WAIT_V(n) asm volatile("s_waitcnt vmcnt(" #n ")" ::: "memory")
#define PG8_WAIT_L(n) asm volatile("s_waitcnt lgkmcnt(" #n ")" ::: "memory")
#define PG8_BAR __builtin_amdgcn_s_barrier()
#define PG8_SCHED __builtin_amdgcn_sched_barrier(0)
    Unit cur, nxt; int ui = 0;
    if (!S.next(0, cur)) return;
    f32x4 acc[2][2][4][2];
#pragma unroll
    for (int a = 0; a < 2; ++a)
#pragma unroll
        for (int b = 0; b < 2; ++b)
#pragma unroll
            for (int m = 0; m < 4; ++m)
#pragma unroll
                for (int n = 0; n < 2; ++n) acc[a][b][m][n] = (f32x4){0.f, 0.f, 0.f, 0.f};
    bf16x8 At[4][2], B0[2][2], B1[2][2];
    const char* cA = (const char*)g.A + (size_t)cur.pm * tstep + cur.koff; const char* cB = (const char*)g.Bt + (size_t)cur.pn * tstep + cur.koff;
    S.a_ready(cur);
    if constexpr (SP2) {
        PG8_STAGE(PG8_SB(0, 0), cB, voffB); PG8_STAGE(PG8_SB(0, 1), cB + hstep, voffB); PG8_STAGE(PG8_SA(0, 0), cA, voffA); PG8_STAGE(PG8_SA(0, 1), cA + hstep, voffA);
        if (wr == 1) PG8_BAR;
        PG8_WAIT_V(2); PG8_BAR;
        PG8_STAGE(PG8_SB(1, 0), cB + kstep, voffB); PG8_STAGE(PG8_SA(1, 0), cA + kstep, voffA); PG8_STAGE(PG8_SB(1, 1), cB + hstep + kstep, voffB);
        PG8_WAIT_V(6); PG8_BAR;
    } else {
        PG8_STAGE(PG8_SB(0, 0), cB, voffB); PG8_STAGE(PG8_SA(0, 0), cA, voffA); PG8_STAGE(PG8_SB(0, 1), cB + hstep, voffB); PG8_STAGE(PG8_SA(0, 1), cA + hstep, voffA);
        if (wr == 1) PG8_BAR;
        PG8_WAIT_V(4); PG8_BAR;
        PG8_STAGE(PG8_SB(1, 0), cB + kstep, voffB); PG8_STAGE(PG8_SA(1, 0), cA + kstep, voffA); PG8_STAGE(PG8_SB(1, 1), cB + hstep + kstep, voffB);
        PG8_WAIT_V(6); PG8_BAR;
    }
    for (;;) {
        const bool has_next = S.next(ui + 1, nxt);
        const char* nA = has_next ? (const char*)g.A + (size_t)nxt.pm * tstep + nxt.koff : cA; const char* nB = has_next ? (const char*)g.Bt + (size_t)nxt.pn * tstep + nxt.koff : cB;
        const int nt = cur.nt;
        for (int t = 0; t < nt; t += 2) {
            const bool last = (t == nt - 2);
            const char* a1 = cA + (size_t)(t + 1) * kstep;
            const char* a2 = last ? nA : cA + (size_t)(t + 2) * kstep; const char* b2 = last ? nB : cB + (size_t)(t + 2) * kstep;
            const char* a3 = a2 + kstep; const char* b3 = b2 + kstep;
            if (last && has_next) S.a_ready(nxt);
            if constexpr (SP2) {
            PG8_LDB(B0, 0, 0); PG8_LDB(B1, 0, 1); PG8_SCHED; PG8_LDA(At, 0, 0); PG8_STAGE(PG8_SA(1, 1), a1 + hstep, voffA);
            PG8_WAIT_V(8); PG8_WAIT_L(0); PG8_BAR; PG8_MMA(0, 0, At, B0); PG8_MMA(0, 1, At, B1); PG8_BAR; PG8_SCHED;
            PG8_LDA(At, 0, 1); PG8_STAGE(PG8_SB(0, 0), b2, voffB); PG8_STAGE(PG8_SB(0, 1), b2 + hstep, voffB); PG8_STAGE(PG8_SA(0, 0), a2, voffA);
            PG8_WAIT_V(8); PG8_WAIT_L(0); PG8_BAR; PG8_MMA(1, 0, At, B0); PG8_MMA(1, 1, At, B1); PG8_BAR; PG8_SCHED;
            PG8_LDB(B0, 1, 0); PG8_LDB(B1, 1, 1); PG8_SCHED; PG8_LDA(At, 1, 0); PG8_STAGE(PG8_SA(0, 1), a2 + hstep, voffA);
            PG8_WAIT_V(8); PG8_WAIT_L(0); PG8_BAR; PG8_MMA(0, 0, At, B0); PG8_MMA(0, 1, At, B1); PG8_BAR; PG8_SCHED;
            PG8_LDA(At, 1, 1); PG8_STAGE(PG8_SB(1, 0), b3, voffB); PG8_STAGE(PG8_SB(1, 1), b3 + hstep, voffB); PG8_STAGE(PG8_SA(1, 0), a3, voffA);
            PG8_WAIT_V(8); PG8_WAIT_L(0); PG8_BAR; PG8_MMA(1, 0, At, B0); PG8_MMA(1, 1, At, B1); PG8_BAR; PG8_SCHED;
            } else {
            PG8_LDB(B0, 0, 0); PG8_SCHED; PG8_LDA(At, 0, 0); PG8_STAGE(PG8_SA(1, 1), a1 + hstep, voffA);
            PG8_WAIT_L(8); PG8_BAR; PG8_WAIT_L(0); PG8_MMA(0, 0, At, B0); PG8_BAR; PG8_SCHED;
            PG8_LDB(B1, 0, 1); PG8_STAGE(PG8_SB(0, 0), b2, voffB);
            PG8_BAR; PG8_WAIT_L(0); PG8_MMA(0, 1, At, B1); PG8_BAR;
            PG8_LDA(At, 0, 1); PG8_STAGE(PG8_SA(0, 0), a2, voffA);
            PG8_BAR; PG8_WAIT_L(0); PG8_MMA(1, 0, At, B0); PG8_BAR; PG8_SCHED;
            PG8_STAGE(PG8_SB(0, 1), b2 + hstep, voffB);
            PG8_WAIT_V(6); PG8_BAR; PG8_MMA(1, 1, At, B1); PG8_BAR;
            PG8_LDB(B0, 1, 0); PG8_SCHED; PG8_LDA(At, 1, 0); PG8_STAGE(PG8_SA(0, 1), a2 + hstep, voffA);
            PG8_WAIT_L(8); PG8_BAR; PG8_WAIT_L(0); PG8_MMA(0, 0, At, B0); PG8_BAR; PG8_SCHED;
            PG8_LDB(B1, 1, 1); PG8_STAGE(PG8_SB(1, 0), b3, voffB);
            PG8_BAR; PG8_WAIT_L(0); PG8_MMA(0, 1, At, B1); PG8_BAR;
            PG8_LDA(At, 1, 1); PG8_STAGE(PG8_SA(1, 0), a3, voffA);
            PG8_BAR; PG8_WAIT_L(0); PG8_MMA(1, 0, At, B0); PG8_BAR; PG8_SCHED;
            PG8_STAGE(PG8_SB(1, 1), b3 + hstep, voffB);
            PG8_WAIT_V(6); PG8_BAR; PG8_MMA(1, 1, At, B1); PG8_BAR;
            }
        }
        if constexpr (ALIGN_EPI) { if (wr == 0) PG8_BAR; }
        if constexpr (!Epi::AFTER_DRAIN) { E(acc, cur, wr, wc, fr, fq); S.done(cur); }
        if (!has_next) break;
        if (!Epi::keep_acc(nxt)) {
#pragma unroll
        for (int a = 0; a < 2; ++a)
#pragma unroll
            for (int b = 0; b < 2; ++b)
#pragma unroll
                for (int m = 0; m < 4; ++m)
#pragma unroll
                    for (int n = 0; n < 2; ++n) acc[a][b][m][n] = (f32x4){0.f, 0.f, 0.f, 0.f};
        }
        cur = nxt; cA = nA; cB = nB; ++ui;
        if constexpr (ALIGN_EPI) { if (wr == 1) PG8_BAR; }
    }
    PG8_WAIT_V(0);
    if constexpr (!ALIGN_EPI) { if (wr == 0) PG8_BAR; }
    PG8_BAR;
    if constexpr (Epi::AFTER_DRAIN) { E.fused(acc, cur, wr, wc, fr, fq, lds, wid, lane); S.done(cur); }
#undef PG8_SA
#undef PG8_SB
#undef PG8_STAGE
#undef PG8_LDA
#undef PG8_LDB
#undef PG8_MMA
#undef PG8_WAIT_V
#undef PG8_WAIT_L
#undef PG8_BAR
#undef PG8_SCHED
}
}

#define LAS __attribute__((address_space(3)))
typedef unsigned short bf16_t;
typedef short bf16x8 __attribute__((ext_vector_type(8)));
typedef short s16x4 __attribute__((ext_vector_type(4)));
typedef float f32x4 __attribute__((ext_vector_type(4)));
typedef float f32x16 __attribute__((ext_vector_type(16)));
typedef unsigned u32x4 __attribute__((ext_vector_type(4)));
typedef unsigned u32x2 __attribute__((ext_vector_type(2)));
typedef float f32x2_t __attribute__((ext_vector_type(2)));
typedef __bf16 bf16x2_t __attribute__((ext_vector_type(2)));

constexpr int DM = 1024, NBATCH = 8, SEQ = 2048, DEPTH = 4, CTXL = 256;
constexpr int ML = NBATCH * SEQ, MC = NBATCH * CTXL, MT = ML + MC;
constexpr int INC = 6656, ZC = 1536, GCOLS = 3072, DFF = 4096;
constexpr int KVT = 2304, KVROW = 256;
constexpr int NMT = MT / 256;
constexpr size_t MiB = (size_t)1 << 20;
constexpr size_t WS_WIN = 0, WS_WBR = 13 * MiB, WS_WOUT = 16 * MiB, WS_W1 = 18 * MiB, WS_W2 = 26 * MiB, WS_XC = 34 * MiB,
                 WS_MOD = 42 * MiB, WS_ROPE = 43 * MiB, WS_CTL = 43 * MiB + 512 * 1024, WS_A3 = 44 * MiB, WS_Z1 = 98 * MiB, WS_G = 224 * MiB, WS_PART = 332 * MiB, WS_WSET1 = 396 * MiB, WS_END = 430 * MiB;
constexpr size_t WS_HN = WS_A3, WS_KVD = WS_Z1 + 54 * MiB, WS_KVN = WS_Z1 + 90 * MiB, WS_MB = WS_Z1 + 72 * MiB, WS_H = WS_Z1;
constexpr int LDS_BYTES = 155648;
constexpr float LOG2E = 1.4426950408889634f;

struct Params {
    const float *x, *c, *ctx, *c_ctx, *w_ada, *b_ada, *g_mix, *g_mlp, *w_in, *lq1, *lk1, *lq2, *lk2, *g_subln, *pool_w, *pool_scale,
                *nat_rpb, *w_branch, *w_out, *w_mlp1, *w_mlp2, *g_final;
    float* out; unsigned char* ws;
};

__device__ __forceinline__ unsigned cvtpk(float lo, float hi) { f32x2_t v = {lo, hi}; bf16x2_t b = __builtin_convertvector(v, bf16x2_t); return __builtin_bit_cast(unsigned, b); }
__device__ __forceinline__ float bf2f(unsigned short v) { return __uint_as_float((unsigned)v << 16); }
__device__ __forceinline__ float wave_sum(float v) {
#pragma unroll
    for (int o = 1; o < 64; o <<= 1) v += __shfl_xor(v, o);
    return v;
}
__device__ __forceinline__ float* xrow_ptr(const Params& p, int row) { return row < ML ? p.out + (size_t)row * DM : (float*)(p.ws + WS_XC) + (size_t)(row - ML) * DM; }

#define XB_TMO      128
#define XB_XCNT(j)  (256  + 64 * (j))
#define XB_XSUB(j)  (1280 + 64 * (j))
#define XB_XGEN(j)  (2304 + 64 * (j))
#define XB_TOP      3328
#define XB_TOPGEN   3392
#define XCD_BAR_WORDS 3456
#define XB_SPIN_CAP (1u << 18)

__device__ __forceinline__ unsigned xb_ld(unsigned* p)              { return __hip_atomic_load(p, __ATOMIC_RELAXED, __HIP_MEMORY_SCOPE_AGENT); }
__device__ __forceinline__ unsigned xb_add(unsigned* p, unsigned v) { return __hip_atomic_fetch_add(p, v, __ATOMIC_RELAXED, __HIP_MEMORY_SCOPE_AGENT); }
__device__ __forceinline__ unsigned xb_xcc_id() { return (unsigned)__builtin_amdgcn_s_getreg((3 << 11) | 20) & 0xFu; }
#define XB_SPIN(cond, bar) do { unsigned _sp = 0; while (cond) { __builtin_amdgcn_s_sleep(1); \
    if ((++_sp & 255u) == 0u) { if (xb_ld(&(bar)[XB_TMO])) break; if (_sp > XB_SPIN_CAP) { atomicAdd(&(bar)[XB_TMO], 1u); break; } } } } while (0)

struct XcdBarrier {
    unsigned* bar; unsigned x;
    volatile LAS unsigned* st;
};

__device__ __forceinline__ XcdBarrier xcd_barrier_post(unsigned* bar, volatile LAS unsigned* st) {
    XcdBarrier b; b.bar = bar; b.x = xb_xcc_id(); b.st = st;
    if (threadIdx.x == 0) (void)xb_add(&bar[XB_XCNT(b.x)], 1u);
    return b;
}
__device__ __forceinline__ void xcd_barrier_complete(unsigned* bar, unsigned x, unsigned& nloc, unsigned& nx) {
    const unsigned G = gridDim.x * gridDim.y * gridDim.z;
    unsigned sum, cnt, mine, sp = 0u;
    for (;;) {
        sum = 0u; cnt = 0u; mine = 0u;
#pragma unroll
        for (unsigned j = 0; j < 16; ++j) { const unsigned c = xb_ld(&bar[XB_XCNT(j)]); sum += c; cnt += (c > 0u) ? 1u : 0u; mine = (j == x) ? c : mine; }
        if (sum == G) break;
        __builtin_amdgcn_s_sleep(1);
        if ((++sp & 255u) == 0u) { if (xb_ld(&bar[XB_TMO])) break; if (sp > XB_SPIN_CAP) { atomicAdd(&bar[XB_TMO], 1u); break; } }
    }
    nloc = mine > 0u ? mine : 1u; nx = cnt > 0u ? cnt : 1u;
}

__device__ __forceinline__ void xcd_barrier(const XcdBarrier& b) {
    asm volatile("s_waitcnt vmcnt(0)" ::: "memory");
    __syncthreads();
    if (threadIdx.x == 0) {
        unsigned* bar = b.bar;
        __builtin_amdgcn_s_waitcnt(0);
        unsigned nloc = b.st[0], nx = b.st[1];
        if (nloc == 0u) { xcd_barrier_complete(bar, b.x, nloc, nx); b.st[0] = nloc; b.st[1] = nx; }
        const unsigned old = xb_add(&bar[XB_XSUB(b.x)], 1u);
        const unsigned gen = old / nloc;
        if (old + 1u == (gen + 1u) * nloc) {
            __builtin_amdgcn_fence(__ATOMIC_RELEASE, "agent");
            asm volatile("s_waitcnt vmcnt(0)" ::: "memory");
            const unsigned og = xb_add(&bar[XB_TOP], 1u);
            const unsigned tg = og / nx;
            if (og + 1u == (tg + 1u) * nx) xb_add(&bar[XB_TOPGEN], 1u);
            else XB_SPIN(xb_ld(&bar[XB_TOPGEN]) == tg, bar);
            __builtin_amdgcn_fence(__ATOMIC_ACQUIRE, "agent");
            xb_add(&bar[XB_XGEN(b.x)], 1u);
            asm volatile("s_waitcnt vmcnt(0)" ::: "memory");
        } else {
            XB_SPIN(xb_ld(&bar[XB_XGEN(b.x)]) == gen, bar);
            __builtin_amdgcn_fence(__ATOMIC_ACQUIRE, "agent");
            asm volatile("s_waitcnt vmcnt(0)" ::: "memory");
        }
    }
    __syncthreads();
}

struct EpiInProj {
    static constexpr bool PERM = true, AFTER_DRAIN = false;
    static __device__ __forceinline__ bool keep_acc(const pg8::Unit&) { return false; }
    bf16_t* Z1; bf16_t* G; const float* rope; bf16_t* KVD; bf16_t* KVN;
    __device__ __forceinline__ void operator()(const f32x4 (&acc)[2][2][4][2], const pg8::Unit& u, int wr, int wc, int fr, int fq) const {
        const int pn = u.pn;
        if (pn < 14) {
            const bool rope_tile = pn < 4;
            const int kind = pn >> 1;
            const bool tokmajor = (kind == 0) || (kind == 3) || (kind == 4);
            const int zoff = (kind == 0 ? 0 : kind == 3 ? 512 : 1024) + (pn & 1) * 256;
            bf16_t* kvb = (kind <= 2 ? KVD : KVN) + ((kind == 2 || kind == 6) ? 128 : 0);
            f32x4 csq[16];
#pragma unroll
            for (int k = 0; k < 8; ++k) {
                const int row = u.pm * 256 + (k >> 2) * 128 + wr * 64 + (k & 3) * 16 + fr;
                if (rope_tile && row < ML) {
                    const int pos = (wc & 1) ? (row & 63) : ((row >> 6) & 31);
                    const f32x4* t = (const f32x4*)(rope + pos * 32 + fq * 8);
                    csq[2 * k] = t[0]; csq[2 * k + 1] = t[1];
                } else { csq[2 * k] = (f32x4){1.f, 0.f, 1.f, 0.f}; csq[2 * k + 1] = (f32x4){1.f, 0.f, 1.f, 0.f}; }
            }
            __builtin_amdgcn_sched_barrier(0);
#pragma unroll
            for (int ai = 0; ai < 2; ++ai)
#pragma unroll
                for (int m = 0; m < 4; ++m) {
                    const int row = u.pm * 256 + ai * 128 + wr * 64 + m * 16 + fr;
                    const f32x4 cs0 = csq[2 * (ai * 4 + m)], cs1 = csq[2 * (ai * 4 + m) + 1];
                    const int bb = row < ML ? (row >> 11) : ((row - ML) >> 8), tt = row < ML ? 256 + (row & 2047) : ((row - ML) & 255);
                    bf16_t* rp = tokmajor ? Z1 + (size_t)row * ZC + zoff + wc * 32 + fq * 8
                                          : kvb + ((size_t)(bb * 4 + (pn & 1) * 2) * KVT + tt) * KVROW + wc * 32 + fq * 8;
                    const size_t bjs = tokmajor ? (size_t)128 : (size_t)KVT * KVROW;
#pragma unroll
                    for (int bj = 0; bj < 2; ++bj) {
                        const f32x4 u1 = acc[ai][bj][m][0], u2 = acc[ai][bj][m][1];
                        f32x4 n1, n2;
                        n1[0] = u1[0] * cs0[0] - u2[0] * cs0[1]; n2[0] = u1[0] * cs0[1] + u2[0] * cs0[0];
                        n1[1] = u1[1] * cs0[2] - u2[1] * cs0[3]; n2[1] = u1[1] * cs0[3] + u2[1] * cs0[2];
                        n1[2] = u1[2] * cs1[0] - u2[2] * cs1[1]; n2[2] = u1[2] * cs1[1] + u2[2] * cs1[0];
                        n1[3] = u1[3] * cs1[2] - u2[3] * cs1[3]; n2[3] = u1[3] * cs1[3] + u2[3] * cs1[2];
                        u32x4 w_; w_.x = cvtpk(n1[0], n1[1]); w_.y = cvtpk(n1[2], n1[3]); w_.z = cvtpk(n2[0], n2[1]); w_.w = cvtpk(n2[2], n2[3]);
                        *(u32x4*)(rp + bj * bjs) = w_;
                    }
                }
        } else {
            const int sub = (pn - 14) >> 2, pn4 = (pn - 14) & 3;
            bf16_t* gp = G + ((((size_t)(sub * NMT + u.pm) * 4 + pn4) * 8 + (wr * 4 + wc)) * 64 + (fq * 16 + fr)) * 128;
#pragma unroll
            for (int ai = 0; ai < 2; ++ai)
#pragma unroll
                for (int m = 0; m < 4; ++m)
#pragma unroll
                    for (int bj = 0; bj < 2; ++bj) {
                        f32x4 s0v, s1v; const f32x4 v0 = acc[ai][bj][m][0], v1 = acc[ai][bj][m][1];
#pragma unroll
                        for (int e = 0; e < 4; ++e) { s0v[e] = __builtin_amdgcn_rcpf(1.0f + __expf(-v0[e])); s1v[e] = __builtin_amdgcn_rcpf(1.0f + __expf(-v1[e])); }
                        u32x4 w; w.x = cvtpk(s0v[0], s0v[1]); w.y = cvtpk(s0v[2], s0v[3]); w.z = cvtpk(s1v[0], s1v[1]); w.w = cvtpk(s1v[2], s1v[3]);
                        *(u32x4*)(gp + ((ai * 4 + m) * 2 + bj) * 8) = w;
                    }
        }
    }
};

struct EpiBranch {
    static constexpr bool PERM = true, AFTER_DRAIN = false;
    static __device__ __forceinline__ bool keep_acc(const pg8::Unit& nxt) { return (nxt.pn >> 2) != 0; }
    const bf16_t* G; bf16_t* MB;
    __device__ __forceinline__ void operator()(f32x4 (&acc)[2][2][4][2], const pg8::Unit& u, int wr, int wc, int fr, int fq) const {
        const int sub = u.pn >> 2, pn = u.pn & 3, pm = u.pm - sub * NMT;
        constexpr size_t SUBSTRIDE = (size_t)NMT * 4 * 8 * 64 * 128;
        const bf16_t* gp = G + ((((size_t)(sub * NMT + pm) * 4 + pn) * 8 + (wr * 4 + wc)) * 64 + (fq * 16 + fr)) * 128;
#define UNPK_LO(w) __uint_as_float((w) << 16)
#define UNPK_HI(w) __uint_as_float((w) & 0xffff0000u)
#pragma unroll
        for (int ai = 0; ai < 2; ++ai) {
            u32x4 gw[8], hw[8];
#pragma unroll
            for (int k = 0; k < 8; ++k) gw[k] = *(const u32x4*)(gp + (ai * 8 + k) * 8);
            if (sub < 2) {
#pragma unroll
                for (int k = 0; k < 8; ++k) hw[k] = *(const u32x4*)(gp + SUBSTRIDE + (ai * 8 + k) * 8);
            }
            __builtin_amdgcn_sched_barrier(0);
#pragma unroll
            for (int m = 0; m < 4; ++m)
#pragma unroll
                for (int bj = 0; bj < 2; ++bj) {
                    const u32x4 g_ = gw[m * 2 + bj];
                    f32x4 g0 = {UNPK_LO(g_.x), UNPK_HI(g_.x), UNPK_LO(g_.y), UNPK_HI(g_.y)}, g1 = {UNPK_LO(g_.z), UNPK_HI(g_.z), UNPK_LO(g_.w), UNPK_HI(g_.w)};
                    if (sub < 2) {
                        const u32x4 h_ = hw[m * 2 + bj];
                        const f32x4 h0 = {UNPK_LO(h_.x), UNPK_HI(h_.x), UNPK_LO(h_.y), UNPK_HI(h_.y)}, h1 = {UNPK_LO(h_.z), UNPK_HI(h_.z), UNPK_LO(h_.w), UNPK_HI(h_.w)};
#pragma unroll
                        for (int e2 = 0; e2 < 4; ++e2) { acc[ai][bj][m][0][e2] *= g0[e2] * __builtin_amdgcn_rcpf(h0[e2]); acc[ai][bj][m][1][e2] *= g1[e2] * __builtin_amdgcn_rcpf(h1[e2]); }
                    } else {
                        const int row = pm * 256 + ai * 128 + wr * 64 + m * 16 + fr, col0 = pn * 256 + wc * 32 + fq * 8;
                        const f32x4 v0 = acc[ai][bj][m][0] * g0, v1 = acc[ai][bj][m][1] * g1;
                        u32x4 w_; w_.x = cvtpk(v0[0], v0[1]); w_.y = cvtpk(v0[2], v0[3]); w_.z = cvtpk(v1[0], v1[1]); w_.w = cvtpk(v1[2], v1[3]);
                        *(u32x4*)(MB + (size_t)row * DM + col0 + bj * 128) = w_;
                    }
                }
            __builtin_amdgcn_sched_barrier(0);
        }
#undef UNPK_LO
#undef UNPK_HI
    }
};
struct BranchOrder {
    int nctx_tiles, G, c;
    __device__ __forceinline__ bool next(int i, pg8::Unit& u) const {
        const int t = i / 3, sub = i - 3 * t, x = c & 7, sl = c >> 3;
        bool ok; int pm, pn;
        if (G == 256) { ok = (t == 0) || (t == 1 && nctx_tiles > 0 && sl < 4); pm = t == 0 ? x + 8 * (sl >> 2) : 64 + x; pn = sl & 3; }
        else { const long L = (long)t * G + c; ok = L < 256 + nctx_tiles; pm = (int)(L >> 2); pn = (int)(L & 3); }
        u.pm = sub * NMT + pm; u.pn = sub * 4 + pn; u.koff = 0; u.nt = 8; u.ks = 0; return ok;
    }
    __device__ __forceinline__ void a_ready(const pg8::Unit&) const {}
    __device__ __forceinline__ void done(const pg8::Unit&) const {}
};

struct InProjOrder {
    pg8::StaticOrder lat, ctxo; int G, c, full;
    __device__ __forceinline__ void init(int G_, int c_, int full_) { lat.init(ML, INC, G_, c_, DM); ctxo.init(MC, INC, G_, c_, DM); G = G_; c = c_; full = full_; }
    __device__ __forceinline__ bool next(int i, pg8::Unit& u) const {
        const long L = (long)i * G + c;
        const int nlat = 64 * 26;
        pg8::Unit a; a.pm = 0; a.pn = 0; a.koff = 0; a.nt = 16; a.ks = 0;
        const bool islat = L < nlat;
        (void)lat.next(islat ? i : 0, a);
        const int k = (int)(L - nlat);
        const int nctx = full ? 8 * 26 : 8 * 8;
        int cpm, cpn;
        if (full) { cpm = k / 26; cpn = k - cpm * 26; } else { cpm = k >> 3; const int t = k & 7; cpn = t < 4 ? 2 + t : 6 + t; }
        u.pm = islat ? a.pm : 64 + cpm; u.pn = islat ? a.pn : cpn; u.koff = 0; u.nt = 16; u.ks = 0;
        return islat ? true : (k < nctx);
    }
    __device__ __forceinline__ void a_ready(const pg8::Unit&) const {}
    __device__ __forceinline__ void done(const pg8::Unit&) const {}
};

struct SplitOrder {
    pg8::StaticOrder lat; int G, c, nlat, K, split;
    __device__ __forceinline__ void init(int G_, int c_, int K_, int split_) { lat.init(ML, DM, G_, c_, K_); G = G_; c = c_; K = K_; split = split_; nlat = c_ < 256 ? (256 - c_ + G_ - 1) / G_ : 0; }
    __device__ __forceinline__ bool next(int i, pg8::Unit& u) const {
        const bool islat = i < nlat;
        pg8::Unit a; a.pm = 0; a.pn = 0; a.koff = 0; a.nt = 2; a.ks = 0;
        const bool oka = lat.next(islat ? i : 0, a);
        const int q = (i - nlat) * G + c, unit = q >> 3, ks = q & 7;
        const bool okp = split && q < 256;
        u.pm = islat ? a.pm : 64 + (unit >> 2); u.pn = islat ? a.pn : (unit & 3); u.nt = islat ? a.nt : K / 512; u.koff = islat ? 0 : ks * (K / 8) * 2; u.ks = islat ? 0 : ks;
        return islat ? oka : okp;
    }
    __device__ __forceinline__ void a_ready(const pg8::Unit&) const {}
    __device__ __forceinline__ void done(const pg8::Unit&) const {}
};

struct EpiResid {
    static constexpr bool PERM = false, AFTER_DRAIN = false;
    static __device__ __forceinline__ bool keep_acc(const pg8::Unit&) { return false; }
    const float* xsrc; float* xl; float* part; const float* mod; int gi;
    __device__ __forceinline__ void operator()(const f32x4 (&acc)[2][2][4][2], const pg8::Unit& u, int wr, int wc, int fr, int fq) const {
        const int bidx = u.pm < 64 ? (u.pm >> 3) : 8;
        const float* gate = mod + (size_t)bidx * 6144 + gi * 1024;
        const int col0 = u.pn * 256 + wc * 32 + fq * 4;
        const int row0 = u.pm * 256 + wr * 64 + fr;
        const bool lat = u.pm < 64;
        float* base = lat ? xl + (size_t)row0 * DM + col0 : part + ((size_t)u.ks * MC + (size_t)(row0 - ML)) * DM + col0;
        const float* rsrc = xsrc + (size_t)row0 * DM + col0;
#pragma unroll
        for (int bj = 0; bj < 2; ++bj) {
            f32x4 gv[2], xv[16];
#pragma unroll
            for (int n = 0; n < 2; ++n) gv[n] = *(const f32x4*)(gate + col0 + bj * 128 + n * 16);
#pragma unroll
            for (int n = 0; n < 2; ++n)
#pragma unroll
                for (int k = 0; k < 8; ++k) xv[n * 8 + k] = lat ? *(const f32x4*)(rsrc + (size_t)((k >> 2) * 128 + (k & 3) * 16) * DM + bj * 128 + n * 16) : (f32x4){0.f, 0.f, 0.f, 0.f};
            __builtin_amdgcn_sched_barrier(0);
#pragma unroll
            for (int n = 0; n < 2; ++n)
#pragma unroll
                for (int ai = 0; ai < 2; ++ai)
#pragma unroll
                    for (int m = 0; m < 4; ++m) {
                        const size_t off = (size_t)(ai * 128 + m * 16) * DM + bj * 128 + n * 16;
                        *(f32x4*)(base + off) = gv[n] * acc[ai][bj][m][n] + xv[n * 8 + ai * 4 + m];
                    }
            __builtin_amdgcn_sched_barrier(0);
        }
    }
};
struct EpiMlp1 {
    static constexpr bool PERM = true, AFTER_DRAIN = false;
    static __device__ __forceinline__ bool keep_acc(const pg8::Unit&) { return false; }
    bf16_t* H;
    __device__ __forceinline__ void operator()(const f32x4 (&acc)[2][2][4][2], const pg8::Unit& u, int wr, int wc, int fr, int fq) const {
        const int col0 = u.pn * 256 + wc * 32 + fq * 8;
#pragma unroll
        for (int ai = 0; ai < 2; ++ai)
#pragma unroll
            for (int m = 0; m < 4; ++m) {
                const int row = u.pm * 256 + ai * 128 + wr * 64 + m * 16 + fr;
                bf16_t* rp = H + (size_t)row * DFF + col0;
#pragma unroll
                for (int bj = 0; bj < 2; ++bj) {
                    f32x4 v0 = acc[ai][bj][m][0], v1 = acc[ai][bj][m][1];
#pragma unroll
                    for (int e = 0; e < 4; ++e) { const float r0 = fmaxf(v0[e], 0.f), r1 = fmaxf(v1[e], 0.f); v0[e] = r0 * r0; v1[e] = r1 * r1; }
                    u32x4 w; w.x = cvtpk(v0[0], v0[1]); w.y = cvtpk(v0[2], v0[3]); w.z = cvtpk(v1[0], v1[1]); w.w = cvtpk(v1[2], v1[3]);
                    *(u32x4*)(rp + bj * 128) = w;
                }
            }
    }
};

namespace att {
constexpr int KPB = 272, VPB = 320;
constexpr int KBUF = 64 * KPB, VBUF = 64 * VPB;
constexpr int OFF_K = 0, OFF_V = 2 * KBUF, OFF_RPB = OFF_V + 2 * VBUF;
typedef short v4i16_t __attribute__((ext_vector_type(4)));

struct TileRegs { u32x4 r[4]; };
__device__ __forceinline__ void tile_load(TileRegs& R, const bf16_t* KVb, int trow0, int tid) {
    const bf16_t* src = KVb + (size_t)trow0 * KVROW + tid * 8;
#pragma unroll
    for (int i = 0; i < 4; ++i) R.r[i] = *(const u32x4*)(src + i * 4096);
}
__device__ __forceinline__ void tile_store(const TileRegs& R, LAS unsigned char* Kb, LAS unsigned char* Vb, int tid) {
    const int ch = tid & 31, row = tid >> 5;
    LAS unsigned char* d = ch < 16 ? Kb + row * KPB + ch * 16 : Vb + row * VPB + (ch - 16) * 16;
    const int step = ch < 16 ? 16 * KPB : 16 * VPB;
#pragma unroll
    for (int i = 0; i < 4; ++i) *(LAS u32x4*)(d + i * step) = R.r[i];
}
__device__ __forceinline__ bf16x8 pack8(const f32x16& s, int b) {
    u32x4 w; w.x = cvtpk(s[b], s[b + 1]); w.y = cvtpk(s[b + 2], s[b + 3]); w.z = cvtpk(s[b + 4], s[b + 5]); w.w = cvtpk(s[b + 6], s[b + 7]);
    return __builtin_bit_cast(bf16x8, w);
}
template <int NDV, int MODE>
__device__ __forceinline__ void attn_qks(LAS const unsigned char* Kt, const bf16x8 (&qf)[4], f32x16 (&o)[NDV], f32x16& lacc, float& m, bf16x8 (&pf)[4],
                                         int r32, int hi, LAS const float* brow, int qc, int cs) {
    bf16x8 kf[8];
#pragma unroll
    for (int ks = 0; ks < 4; ++ks) {
        kf[2 * ks] = *(LAS const bf16x8*)(Kt + r32 * KPB + ks * 32 + hi * 16);
        kf[2 * ks + 1] = *(LAS const bf16x8*)(Kt + (32 + r32) * KPB + ks * 32 + hi * 16);
    }
    float bq0[16], bq1[16];
    if (MODE == 1) {
#pragma unroll
        for (int r = 0; r < 16; ++r) {
            const int kc0 = (r & 3) + 8 * (r >> 2) + 4 * hi, kc1 = kc0 + 32;
            const bool v0 = (unsigned)(kc0 - cs) < 16u, v1 = (unsigned)(kc1 - cs) < 16u;
            bq0[r] = brow[v0 ? (kc0 - qc + 15) : 0]; bq1[r] = brow[v1 ? (kc1 - qc + 15) : 0];
        }
    }
    __builtin_amdgcn_sched_barrier(0);
    f32x16 s0, s1;
#pragma unroll
    for (int r = 0; r < 16; ++r) { s0[r] = 0.f; s1[r] = 0.f; }
#pragma unroll
    for (int ks = 0; ks < 4; ++ks) {
        s0 = __builtin_amdgcn_mfma_f32_32x32x16_bf16(kf[2 * ks], qf[ks], s0, 0, 0, 0);
        s1 = __builtin_amdgcn_mfma_f32_32x32x16_bf16(kf[2 * ks + 1], qf[ks], s1, 0, 0, 0);
    }
    __builtin_amdgcn_sched_barrier(0);
    constexpr float C = 0.125f * LOG2E;
    if (MODE == 1) {
#pragma unroll
        for (int r = 0; r < 16; ++r) {
            const int kc0 = (r & 3) + 8 * (r >> 2) + 4 * hi, kc1 = kc0 + 32;
            const bool v0 = (unsigned)(kc0 - cs) < 16u, v1 = (unsigned)(kc1 - cs) < 16u;
            s0[r] = v0 ? __builtin_fmaf(s0[r], C, bq0[r] * LOG2E) : -1e30f;
            s1[r] = v1 ? __builtin_fmaf(s1[r], C, bq1[r] * LOG2E) : -1e30f;
        }
    }
    float mx = __builtin_fmaxf(s0[0], s1[0]);
#pragma unroll
    for (int r = 1; r < 16; ++r) mx = __builtin_fmaxf(__builtin_fmaxf(mx, s0[r]), s1[r]);
    if (MODE == 0) mx *= C;
    mx = __builtin_fmaxf(mx, __shfl_xor(mx, 32));
    if (__any(mx > m + 8.0f)) {
        const float mn = __builtin_fmaxf(m, mx);
        const float alpha = __builtin_amdgcn_exp2f(m - mn);
        m = mn;
        lacc[0] *= alpha;
#pragma unroll
        for (int d0 = 0; d0 < NDV; ++d0)
#pragma unroll
            for (int r = 0; r < 16; ++r) o[d0][r] *= alpha;
    }
    const float nm = -m;
#pragma unroll
    for (int r = 0; r < 16; ++r) {
        if (MODE == 0) { s0[r] = __builtin_amdgcn_exp2f(__builtin_fmaf(s0[r], C, nm)); s1[r] = __builtin_amdgcn_exp2f(__builtin_fmaf(s1[r], C, nm)); }
        else { s0[r] = __builtin_amdgcn_exp2f(s0[r] + nm); s1[r] = __builtin_amdgcn_exp2f(s1[r] + nm); }
    }
    pf[0] = pack8(s0, 0); pf[1] = pack8(s0, 8); pf[2] = pack8(s1, 0); pf[3] = pack8(s1, 8);
}
template <int NDV>
__device__ __forceinline__ void attn_pv(LAS const unsigned char* Vt, const bf16x8 (&pf)[4], f32x16 (&o)[NDV], f32x16& lacc, int vlane) {
    const bf16x8 ones = {0x3F80, 0x3F80, 0x3F80, 0x3F80, 0x3F80, 0x3F80, 0x3F80, 0x3F80};
#pragma unroll
    for (int dp = 0; dp < NDV; dp += 2) {
        bf16x8 vq[8];
#pragma unroll
        for (int d0 = 0; d0 < 2; ++d0)
#pragma unroll
            for (int s = 0; s < 4; ++s) {
                LAS const unsigned char* vp = Vt + vlane + s * 16 * VPB + (dp + d0) * 64;
                const v4i16_t lo = __builtin_amdgcn_ds_read_tr16_b64_v4i16((LAS v4i16_t*)vp);
                const v4i16_t hh = __builtin_amdgcn_ds_read_tr16_b64_v4i16((LAS v4i16_t*)(vp + 8 * VPB));
                vq[d0 * 4 + s] = (bf16x8){lo[0], lo[1], lo[2], lo[3], hh[0], hh[1], hh[2], hh[3]};
            }
        __builtin_amdgcn_sched_barrier(0);
        if (dp == 0) {
#pragma unroll
            for (int s = 0; s < 4; ++s) lacc = __builtin_amdgcn_mfma_f32_32x32x16_bf16(ones, pf[s], lacc, 0, 0, 0);
        }
#pragma unroll
        for (int s = 0; s < 4; ++s) {
            o[dp] = __builtin_amdgcn_mfma_f32_32x32x16_bf16(vq[s], pf[s], o[dp], 0, 0, 0);
            o[dp + 1] = __builtin_amdgcn_mfma_f32_32x32x16_bf16(vq[4 + s], pf[s], o[dp + 1], 0, 0, 0);
        }
        __builtin_amdgcn_sched_barrier(0);
    }
}
#define ATT_BAR() asm volatile("s_waitcnt lgkmcnt(0)\n\ts_barrier" ::: "memory")

#define ATT_SB() __builtin_amdgcn_sched_barrier(0)
constexpr int OFF3_K = 0, OFF3_V = 3 * KBUF, OFF3_Q = 3 * KBUF + 3 * VBUF;
__device__ __forceinline__ bf16x8 vfrag(LAS const unsigned char* vp) {
    const v4i16_t lo = __builtin_amdgcn_ds_read_tr16_b64_v4i16((LAS v4i16_t*)vp);
    const v4i16_t hh = __builtin_amdgcn_ds_read_tr16_b64_v4i16((LAS v4i16_t*)(vp + 8 * VPB));
    return (bf16x8){lo[0], lo[1], lo[2], lo[3], hh[0], hh[1], hh[2], hh[3]};
}
__device__ __forceinline__ void st_qk(LAS const unsigned char* Kt, LAS const unsigned char* Qt, f32x16& s0, f32x16& s1, int r32, int hi) {
    bf16x8 ka[4], qa[2];
#pragma unroll
    for (int ks = 0; ks < 2; ++ks) {
        ka[2 * ks] = *(LAS const bf16x8*)(Kt + r32 * KPB + ks * 32 + hi * 16);
        ka[2 * ks + 1] = *(LAS const bf16x8*)(Kt + (32 + r32) * KPB + ks * 32 + hi * 16);
        qa[ks] = *(LAS const bf16x8*)(Qt + r32 * KPB + ks * 32 + hi * 16);
    }
    ATT_SB();
#pragma unroll
    for (int r = 0; r < 16; ++r) { s0[r] = 0.f; s1[r] = 0.f; }
#pragma unroll
    for (int ks = 0; ks < 2; ++ks) {
        s0 = __builtin_amdgcn_mfma_f32_32x32x16_bf16(ka[2 * ks], qa[ks], s0, 0, 0, 0);
        s1 = __builtin_amdgcn_mfma_f32_32x32x16_bf16(ka[2 * ks + 1], qa[ks], s1, 0, 0, 0);
    }
    ATT_SB();
    bf16x8 kb[4], qb[2];
#pragma unroll
    for (int ks = 0; ks < 2; ++ks) {
        kb[2 * ks] = *(LAS const bf16x8*)(Kt + r32 * KPB + (ks + 2) * 32 + hi * 16);
        kb[2 * ks + 1] = *(LAS const bf16x8*)(Kt + (32 + r32) * KPB + (ks + 2) * 32 + hi * 16);
        qb[ks] = *(LAS const bf16x8*)(Qt + r32 * KPB + (ks + 2) * 32 + hi * 16);
    }
    ATT_SB();
#pragma unroll
    for (int ks = 0; ks < 2; ++ks) {
        s0 = __builtin_amdgcn_mfma_f32_32x32x16_bf16(kb[2 * ks], qb[ks], s0, 0, 0, 0);
        s1 = __builtin_amdgcn_mfma_f32_32x32x16_bf16(kb[2 * ks + 1], qb[ks], s1, 0, 0, 0);
    }
    ATT_SB();
}
__device__ __forceinline__ void st_softmax(f32x16& s0, f32x16& s1, f32x16 (&o)[4], float& lsum, float& m, bf16x8 (&pf)[4]) {
    constexpr float C = 0.125f * LOG2E;
    float mx = __builtin_fmaxf(s0[0], s1[0]);
#pragma unroll
    for (int r = 1; r < 16; ++r) mx = __builtin_fmaxf(__builtin_fmaxf(mx, s0[r]), s1[r]);
    mx *= C;
    mx = __builtin_fmaxf(mx, __shfl_xor(mx, 32));
    if (__any(mx > m + 8.0f)) {
        const float mn = __builtin_fmaxf(m, mx);
        const float alpha = __builtin_amdgcn_exp2f(m - mn);
        m = mn;
        lsum *= alpha;
#pragma unroll
        for (int d0 = 0; d0 < 4; ++d0)
#pragma unroll
            for (int r = 0; r < 16; ++r) o[d0][r] *= alpha;
    }
    const float nm = -m;
    float rs = 0.f;
#pragma unroll
    for (int r = 0; r < 16; ++r) { s0[r] = __builtin_amdgcn_exp2f(__builtin_fmaf(s0[r], C, nm)); s1[r] = __builtin_amdgcn_exp2f(__builtin_fmaf(s1[r], C, nm)); rs += s0[r] + s1[r]; }
    lsum += rs;
    pf[0] = pack8(s0, 0); pf[1] = pack8(s0, 8); pf[2] = pack8(s1, 0); pf[3] = pack8(s1, 8);
#pragma unroll
    for (int q_ = 0; q_ < 32; ++q_) { __builtin_amdgcn_sched_group_barrier(0x400, 1, 0); __builtin_amdgcn_sched_group_barrier(0x002, 3, 0); }
}
__device__ __forceinline__ void st_pv(LAS const unsigned char* Vt, const bf16x8 (&va)[4], const bf16x8 (&pf)[4], f32x16 (&o)[4], int vlane) {
    ATT_SB();
#pragma unroll
    for (int s = 0; s < 4; ++s) o[0] = __builtin_amdgcn_mfma_f32_32x32x16_bf16(va[s], pf[s], o[0], 0, 0, 0);
    ATT_SB();
    bf16x8 vb[4];
#pragma unroll
    for (int s = 0; s < 4; ++s) vb[s] = vfrag(Vt + vlane + s * 16 * VPB + 1 * 64);
    ATT_SB();
#pragma unroll
    for (int s = 0; s < 4; ++s) o[1] = __builtin_amdgcn_mfma_f32_32x32x16_bf16(vb[s], pf[s], o[1], 0, 0, 0);
    ATT_SB();
    bf16x8 vc[4];
#pragma unroll
    for (int s = 0; s < 4; ++s) vc[s] = vfrag(Vt + vlane + s * 16 * VPB + 2 * 64);
    ATT_SB();
#pragma unroll
    for (int s = 0; s < 4; ++s) o[2] = __builtin_amdgcn_mfma_f32_32x32x16_bf16(vc[s], pf[s], o[2], 0, 0, 0);
    ATT_SB();
    bf16x8 vd[4];
#pragma unroll
    for (int s = 0; s < 4; ++s) vd[s] = vfrag(Vt + vlane + s * 16 * VPB + 3 * 64);
    ATT_SB();
#pragma unroll
    for (int s = 0; s < 4; ++s) o[3] = __builtin_amdgcn_mfma_f32_32x32x16_bf16(vd[s], pf[s], o[3], 0, 0, 0);
    ATT_SB();
}

__device__ __forceinline__ void diff_unit(const Params& p, int l, LAS unsigned char* lds, int b, int h, int qrow0, int NT) {
    const int tid = fresh_tid(), lane = tid & 63, w = __builtin_amdgcn_readfirstlane(tid >> 6), r32 = lane & 31, hi = lane >> 5;
    const int map = w >> 2, qs = w & 3;
    const bf16_t* Z1 = (const bf16_t*)(p.ws + WS_Z1);
    const int qrow = qrow0 + qs * 32 + r32;
    {
        u32x4 qv[4];
#pragma unroll
        for (int i = 0; i < 4; ++i) { const int c = tid + 512 * i, row = c >> 4, ch = c & 15; qv[i] = *(const u32x4*)(Z1 + (size_t)(qrow0 + row) * ZC + h * 128 + ch * 8); }
#pragma unroll
        for (int i = 0; i < 4; ++i) { const int c = tid + 512 * i, row = c >> 4, ch = c & 15; *(LAS u32x4*)(lds + OFF3_Q + row * KPB + ch * 16) = qv[i]; }
    }
    LAS const unsigned char* Qt = lds + OFF3_Q + (qs * 32) * KPB + map * 128;
    const bf16_t* KVb = (const bf16_t*)(p.ws + WS_KVD) + (size_t)(b * 4 + h) * KVT * KVROW;
    const int vlane = (4 * hi + ((lane & 15) >> 2)) * VPB + ((lane >> 4) & 1) * 32 + (lane & 3) * 8;
    f32x16 o[4];
#pragma unroll
    for (int d0 = 0; d0 < 4; ++d0)
#pragma unroll
        for (int r = 0; r < 16; ++r) o[d0][r] = 0.f;
    float m = -1e30f, lsum = 0.f;
    TileRegs R;
#define DIFF_TROW(j) ((j) * 64)
    tile_load(R, KVb, DIFF_TROW(0), tid);
    tile_store(R, lds + OFF3_K, lds + OFF3_V, tid);
    if (1 < NT) { tile_load(R, KVb, DIFF_TROW(1), tid); tile_store(R, lds + OFF3_K + KBUF, lds + OFF3_V + VBUF, tid); }
    if (2 < NT) tile_load(R, KVb, DIFF_TROW(2), tid);
    __syncthreads();
    f32x16 sa0, sa1, sb0, sb1;
    st_qk(lds + OFF3_K + map * 128, Qt, sa0, sa1, r32, hi);
    int bj = 0;
#define DIFF_STEP(jj, SC0, SC1, SN0, SN1) do { \
        const int b1 = (bj == 2) ? 0 : bj + 1, b2 = (b1 == 2) ? 0 : b1 + 1; \
        if ((jj) + 2 < NT) tile_store(R, lds + OFF3_K + b2 * KBUF, lds + OFF3_V + b2 * VBUF, tid); \
        if ((jj) + 3 < NT) tile_load(R, KVb, DIFF_TROW((jj) + 3), tid); \
        if ((jj) + 1 < NT) st_qk(lds + OFF3_K + b1 * KBUF + map * 128, Qt, SN0, SN1, r32, hi); \
        LAS const unsigned char* Vt_ = lds + OFF3_V + bj * VBUF; \
        bf16x8 pf_[4]; \
        st_softmax(SC0, SC1, o, lsum, m, pf_); \
        ATT_SB(); \
        bf16x8 va_[4]; \
        _Pragma("unroll") for (int s_ = 0; s_ < 4; ++s_) va_[s_] = vfrag(Vt_ + vlane + s_ * 16 * VPB); \
        st_pv(Vt_, va_, pf_, o, vlane); \
        ATT_BAR(); \
        bj = b1; \
    } while (0)
    for (int j = 0; j < NT; j += 2) {
        DIFF_STEP(j, sa0, sa1, sb0, sb1);
        if (j + 1 < NT) DIFF_STEP(j + 1, sb0, sb1, sa0, sa1);
    }
#undef DIFF_STEP
    __syncthreads();
#undef DIFF_TROW
    int l_ = l; asm volatile("" : "+s"(l_));
    const float lam_init = l_ == 0 ? 0.200000000f : l_ == 1 ? 0.355509068f : l_ == 2 ? 0.470713018f : 0.556058204f;
    float lam;
    { const float a_ = p.lq1[l * 64 + lane] * p.lk1[l * 64 + lane], b_ = p.lq2[l * 64 + lane] * p.lk2[l * 64 + lane];
      lam = __expf(wave_sum(a_)) - __expf(wave_sum(b_)) + lam_init; }
    const float inv = 1.0f / (lsum + __shfl_xor(lsum, 32));
    LAS float* X = (LAS float*)lds;
    if (map == 1) {
        const float f = -lam * inv;
#pragma unroll
        for (int d0 = 0; d0 < 4; ++d0)
#pragma unroll
            for (int r = 0; r < 16; ++r) X[((qs * 4 + d0) * 16 + r) * 64 + lane] = o[d0][r] * f;
    }
    __syncthreads();
    if (map == 0) {
        f32x4 gq_[16];
        { const float* gs0 = p.g_subln + l * 128;
#pragma unroll
          for (int k = 0; k < 16; ++k) gq_[k] = *(const f32x4*)(gs0 + 32 * (k >> 2) + 8 * (k & 3) + 4 * hi); }
        __builtin_amdgcn_sched_barrier(0);
        float ss = 0.f;
#pragma unroll
        for (int d0 = 0; d0 < 4; ++d0)
#pragma unroll
            for (int r = 0; r < 16; ++r) { const float v = o[d0][r] * inv + X[((qs * 4 + d0) * 16 + r) * 64 + lane]; o[d0][r] = v; ss += v * v; }
        ss += __shfl_xor(ss, 32);
        const float rstd = rsqrtf(ss * (1.0f / 128.0f) + 1e-6f) * (1.0f - lam_init);
        bf16_t* orow = (bf16_t*)(p.ws + WS_A3) + (size_t)qrow * 512 + h * 128;
        const float* gs = p.g_subln + l * 128;
#pragma unroll
        for (int d0 = 0; d0 < 4; ++d0)
#pragma unroll
            for (int a = 0; a < 4; ++a) {
                const int dv = 32 * d0 + 8 * a + 4 * hi;
                const f32x4 g = gq_[d0 * 4 + a];
                u32x2 wv; wv.x = cvtpk(o[d0][4 * a] * rstd * g[0], o[d0][4 * a + 1] * rstd * g[1]); wv.y = cvtpk(o[d0][4 * a + 2] * rstd * g[2], o[d0][4 * a + 3] * rstd * g[3]);
                *(u32x2*)(orow + dv) = wv;
            }
    }
    __syncthreads();
}

__device__ __forceinline__ void nat_unit(const Params& p, int l, LAS unsigned char* lds, int b, int hp, int mode, int idx) {
    const int tid = fresh_tid(), lane = tid & 63, w = __builtin_amdgcn_readfirstlane(tid >> 6), r32 = lane & 31, hi = lane >> 5;
    const int hsel = w & 1, head = 2 * hp + hsel;
    const bf16_t* Z1 = (const bf16_t*)(p.ws + WS_Z1);
    int qrow, qc = 0, cs = 0, grow = 0, s0r = 0, sr = 0, NT = 4;
    if (mode == 0) {
        const int rsel = (w >> 1) & 1, csel = w >> 2;
        grow = 2 * idx + rsel; qc = csel * 32 + r32; cs = min(max(qc - 8, 0), 48);
        qrow = b * 2048 + grow * 64 + qc;
        s0r = min(max(2 * idx - 4, 0), 24); const int s1r = min(max(2 * idx + 1 - 4, 0), 24);
        sr = rsel ? s1r : s0r; NT = 4 + (s1r + 8 - s0r);
    } else {
        const int qs = w >> 1;
        qrow = ML + b * 256 + idx * 128 + qs * 32 + r32;
    }
    bf16x8 qf[4];
#pragma unroll
    for (int ks = 0; ks < 4; ++ks) qf[ks] = *(const bf16x8*)(Z1 + (size_t)qrow * ZC + 1024 + head * 64 + ks * 16 + hi * 8);
    const bf16_t* KVb = (const bf16_t*)(p.ws + WS_KVN) + (size_t)(b * 4 + hp) * KVT * KVROW;
    const int vlane = (4 * hi + ((lane & 15) >> 2)) * VPB + ((lane >> 4) & 1) * 32 + (lane & 3) * 8;
    LAS float* rpbL = (LAS float*)(lds + OFF_RPB);
    { const float* src = p.nat_rpb + (size_t)(l * 8 + 2 * hp) * 465; for (int i = tid; i < 930; i += 512) rpbL[i] = src[i]; }
    f32x16 o[2];
#pragma unroll
    for (int d0 = 0; d0 < 2; ++d0)
#pragma unroll
        for (int r = 0; r < 16; ++r) o[d0][r] = 0.f;
    float m = -1e30f; f32x16 lacc;
#pragma unroll
    for (int r = 0; r < 16; ++r) lacc[r] = 0.f;
    TileRegs R;
#define NAT_TROW(j) ((j) < 4 ? (j) * 64 : 256 + (s0r + (j) - 4) * 64)
    TileRegs Rb;
    tile_load(R, KVb, NAT_TROW(0), tid);
    tile_store(R, lds + OFF_K, lds + OFF_V, tid);
    if (1 < NT) tile_load(R, KVb, NAT_TROW(1), tid);
    if (2 < NT) tile_load(Rb, KVb, NAT_TROW(2), tid);
    __syncthreads();
    bf16x8 pf[4];
#define NAT_STEP(jj, KB, VB) do { \
        LAS const unsigned char* Kt = lds + OFF_K + (KB) + hsel * 128; LAS const unsigned char* Vt = lds + OFF_V + (VB) + hsel * 128; \
        const int kr = s0r + (jj) - 4; \
        if ((jj) < 4) { attn_qks<2, 0>(Kt, qf, o, lacc, m, pf, r32, hi, nullptr, 0, 0); attn_pv<2>(Vt, pf, o, lacc, vlane); } \
        else if (kr >= sr && kr < sr + 8) { attn_qks<2, 1>(Kt, qf, o, lacc, m, pf, r32, hi, rpbL + (hsel * 15 + (kr - grow + 7)) * 31, qc, cs); attn_pv<2>(Vt, pf, o, lacc, vlane); } \
    } while (0)
    for (int j = 0; j < NT; j += 2) {
        NAT_STEP(j, 0, 0);
        if (j + 1 < NT) tile_store(R, lds + OFF_K + KBUF, lds + OFF_V + VBUF, tid);
        if (j + 3 < NT) tile_load(R, KVb, NAT_TROW(j + 3), tid);
        ATT_BAR();
        if (j + 1 < NT) {
            NAT_STEP(j + 1, KBUF, VBUF);
            if (j + 2 < NT) tile_store(Rb, lds + OFF_K, lds + OFF_V, tid);
            if (j + 4 < NT) tile_load(Rb, KVb, NAT_TROW(j + 4), tid);
            ATT_BAR();
        }
    }
#undef NAT_STEP
    __syncthreads();
#undef NAT_TROW
    const float inv = 1.0f / lacc[0];
    bf16_t* orow = (bf16_t*)(p.ws + WS_A3) + (size_t)2 * MT * 512 + (size_t)qrow * 512 + head * 64;
#pragma unroll
    for (int d0 = 0; d0 < 2; ++d0)
#pragma unroll
        for (int a = 0; a < 4; ++a) {
            const int dv = 32 * d0 + 8 * a + 4 * hi;
            u32x2 wv; wv.x = cvtpk(o[d0][4 * a] * inv, o[d0][4 * a + 1] * inv); wv.y = cvtpk(o[d0][4 * a + 2] * inv, o[d0][4 * a + 3] * inv);
            *(u32x2*)(orow + dv) = wv;
        }
}
}

__device__ __forceinline__ void pool_unit(const Params& p, int unit) {
    const int tid = fresh_tid(), lane = tid & 63, w = tid >> 6;
    const bf16_t* Z1 = (const bf16_t*)(p.ws + WS_Z1);
    bf16_t* P = (bf16_t*)(p.ws + WS_A3) + (size_t)MT * 512;
    const int half = 1 << (lane >> 4);
#pragma unroll 2
    for (int i = 0; i < 8; ++i) {
        const int row = unit * 64 + w * 8 + i;
        int sb, t, L;
        if (row < ML) { sb = row & ~2047; t = row & 2047; L = 2048; } else { sb = ML + ((row - ML) & ~255); t = (row - ML) & 255; L = 256; }
        const int lo = max(t - half, 0), hi = min(t + half, L);
        float acc[8];
#pragma unroll
        for (int e = 0; e < 8; ++e) acc[e] = 0.f;
        const bf16_t* base = Z1 + (size_t)sb * ZC + 512 + lane * 8;
        u32x4 wv[16];
#pragma unroll
        for (int k = 0; k < 16; ++k) { const int s_ = lo + k; wv[k] = *(const u32x4*)(base + (size_t)(s_ < hi ? s_ : lo) * ZC); }
        const u32x4 sv = *(const u32x4*)(base + (size_t)t * ZC);
        __builtin_amdgcn_sched_barrier(0);
#pragma unroll
        for (int k = 0; k < 16; ++k) {
            const float f_ = (lo + k < hi) ? 1.0f : 0.0f; const u32x4 v = wv[k];
            acc[0] += f_ * __uint_as_float(v.x << 16); acc[1] += f_ * __uint_as_float(v.x & 0xffff0000u);
            acc[2] += f_ * __uint_as_float(v.y << 16); acc[3] += f_ * __uint_as_float(v.y & 0xffff0000u);
            acc[4] += f_ * __uint_as_float(v.z << 16); acc[5] += f_ * __uint_as_float(v.z & 0xffff0000u);
            acc[6] += f_ * __uint_as_float(v.w << 16); acc[7] += f_ * __uint_as_float(v.w & 0xffff0000u);
        }
        const float ic = 1.0f / (float)(hi - lo);
        float uu[8] = {__uint_as_float(sv.x << 16), __uint_as_float(sv.x & 0xffff0000u), __uint_as_float(sv.y << 16), __uint_as_float(sv.y & 0xffff0000u),
                       __uint_as_float(sv.z << 16), __uint_as_float(sv.z & 0xffff0000u), __uint_as_float(sv.w << 16), __uint_as_float(sv.w & 0xffff0000u)};
        u32x4 ov; ov.x = cvtpk(acc[0] * ic - uu[0], acc[1] * ic - uu[1]); ov.y = cvtpk(acc[2] * ic - uu[2], acc[3] * ic - uu[3]);
        ov.z = cvtpk(acc[4] * ic - uu[4], acc[5] * ic - uu[5]); ov.w = cvtpk(acc[6] * ic - uu[6], acc[7] * ic - uu[7]);
        *(u32x4*)(P + (size_t)row * 512 + lane * 8) = ov;
    }
}

__device__ __forceinline__ void norm_rows(const Params& p, int l, int nrows, const float* gvec, int si, bool use_part, const float* srcL, const float* srcC) {
    const int tid = fresh_tid(), lane = tid & 63, w = tid >> 6;
    bf16_t* HN = (bf16_t*)(p.ws + WS_HN);
    const float* MOD = (const float*)(p.ws + WS_MOD) + (size_t)l * 9 * 6144;
    for (int row = blockIdx.x * 8 + w; row < nrows; row += gridDim.x * 8) {
        const float* xr = row < ML ? srcL + (size_t)row * DM : srcC + (size_t)(row - ML) * DM;
        const int b = row < ML ? (row >> 11) : 8;
        const float* sh = MOD + (size_t)b * 6144 + si * 1024; const float* sc = sh + 1024;
        f32x4 v[4], gq[4], s1q[4], s0q[4]; float ss = 0.f;
#pragma unroll
        for (int j = 0; j < 4; ++j) v[j] = ((const f32x4*)xr)[64 * j + lane];
#pragma unroll
        for (int j = 0; j < 4; ++j) { const int col = (64 * j + lane) * 4; gq[j] = *(const f32x4*)(gvec + col); s1q[j] = *(const f32x4*)(sc + col); s0q[j] = *(const f32x4*)(sh + col); }
        __builtin_amdgcn_sched_barrier(0);
        if (use_part && row >= ML) {
            const f32x4* pp = (const f32x4*)((const float*)(p.ws + WS_PART) + (size_t)(row - ML) * DM);
#pragma unroll
            for (int kh = 0; kh < 2; ++kh) {
                f32x4 pq[16];
#pragma unroll
                for (int k = 0; k < 4; ++k)
#pragma unroll
                    for (int j = 0; j < 4; ++j) pq[k * 4 + j] = pp[(size_t)(kh * 4 + k) * (MC * DM / 4) + 64 * j + lane];
                __builtin_amdgcn_sched_barrier(0);
#pragma unroll
                for (int k = 0; k < 4; ++k)
#pragma unroll
                    for (int j = 0; j < 4; ++j) v[j] += pq[k * 4 + j];
            }
#pragma unroll
            for (int j = 0; j < 4; ++j) ((f32x4*)xrow_ptr(p, row))[64 * j + lane] = v[j];
        }
#pragma unroll
        for (int j = 0; j < 4; ++j) ss += (v[j][0] * v[j][0] + v[j][1] * v[j][1]) + (v[j][2] * v[j][2] + v[j][3] * v[j][3]);
        const float rstd = rsqrtf(wave_sum(ss) * (1.0f / 1024.0f) + 1e-6f);
#pragma unroll
        for (int j = 0; j < 4; ++j) {
            const int col = (64 * j + lane) * 4;
            const f32x4 hv = v[j] * rstd * gq[j] * (s1q[j] + 1.0f) + s0q[j];
            u32x2 wv; wv.x = cvtpk(hv[0], hv[1]); wv.y = cvtpk(hv[2], hv[3]);
            *(u32x2*)(HN + (size_t)row * DM + col) = wv;
        }
    }
}
__device__ __forceinline__ void final_norm(const Params& p) {
    const int tid = fresh_tid(), lane = tid & 63, w = tid >> 6;
    for (int row = blockIdx.x * 8 + w; row < ML; row += gridDim.x * 8) {
        float* xr = p.out + (size_t)row * DM;
        f32x4 v[4], gq[4]; float ss = 0.f;
#pragma unroll
        for (int j = 0; j < 4; ++j) { v[j] = ((const f32x4*)xr)[64 * j + lane]; gq[j] = ((const f32x4*)p.g_final)[64 * j + lane]; }
        __builtin_amdgcn_sched_barrier(0);
#pragma unroll
        for (int j = 0; j < 4; ++j) ss += (v[j][0] * v[j][0] + v[j][1] * v[j][1]) + (v[j][2] * v[j][2] + v[j][3] * v[j][3]);
        const float rstd = rsqrtf(wave_sum(ss) * (1.0f / 1024.0f) + 1e-6f);
#pragma unroll
        for (int j = 0; j < 4; ++j) ((f32x4*)xr)[64 * j + lane] = v[j] * rstd * gq[j];
    }
}
__device__ __forceinline__ void cvt_item(const float* W, int K, int N, bf16_t* WT, int item, LAS float* scr, int lane, int nperm = 0) {
    const int nblk = N >> 5, kb = item / nblk, nb = item - kb * nblk, k0 = kb * 64, n0 = nb * 32;
    const int pl = lane & 31, srcn = (n0 < nperm) ? (16 * ((pl >> 2) & 1) + 4 * (pl >> 3) + (pl & 3)) : pl;
    float wq_[32];
#pragma unroll
    for (int i = 0; i < 32; ++i) wq_[i] = W[(size_t)(k0 + 2 * i + (lane >> 5)) * N + n0 + srcn];
    __builtin_amdgcn_sched_barrier(0);
#pragma unroll
    for (int i = 0; i < 32; ++i) scr[(2 * i + (lane >> 5)) * 33 + (lane & 31)] = wq_[i];
    asm volatile("s_waitcnt lgkmcnt(0)" ::: "memory");
    const int c = lane & 7;
#pragma unroll
    for (int j = 0; j < 4; ++j) { const int n = (lane >> 3) + 8 * j; LAS const float* sp = scr + (8 * c) * 33 + n;
        u32x4 o; o.x = cvtpk(sp[0], sp[33]); o.y = cvtpk(sp[2 * 33], sp[3 * 33]); o.z = cvtpk(sp[4 * 33], sp[5 * 33]); o.w = cvtpk(sp[6 * 33], sp[7 * 33]);
        *(u32x4*)(WT + (size_t)(n0 + n) * K + k0 + 8 * c) = o; }
    asm volatile("s_waitcnt lgkmcnt(0)" ::: "memory");
}
__device__ __forceinline__ void fold_unit(const Params& p, int l, int unit, LAS float* scr, size_t wo) {
    const int tid = fresh_tid(), g = unit >> 5, nt = (unit >> 1) & 15, ct = unit & 1;
    LAS float* As = scr; LAS float* Bs = scr + 64 * 129;
    const float* pw = p.pool_w + ((size_t)(l * 4 + g) * 128 + ct * 64) * 128;
    const float* ps = p.pool_scale + l * 512 + g * 128;
    const float* wb = p.w_branch + ((size_t)(l * 3 + 1) * 512 + g * 128) * 1024 + nt * 64;
    for (int i = tid; i < 64 * 128; i += 512) { const int c = i >> 7, e = i & 127; As[c * 129 + e] = pw[(size_t)c * 128 + e]; }
    for (int i = tid; i < 128 * 64; i += 512) { const int e = i >> 6, n = i & 63; Bs[e * 65 + n] = ps[e] * wb[(size_t)e * 1024 + n]; }
    __syncthreads();
    const int n = tid >> 3, cc = tid & 7;
    float acc[8];
#pragma unroll
    for (int j = 0; j < 8; ++j) acc[j] = 0.f;
    for (int e = 0; e < 128; ++e) {
        const float bv = Bs[e * 65 + n];
#pragma unroll
        for (int j = 0; j < 8; ++j) acc[j] += As[(cc * 8 + j) * 129 + e] * bv;
    }
    bf16_t* dst = (bf16_t*)(p.ws + wo + WS_WBR) + (size_t)(1024 + nt * 64 + n) * 512 + g * 128 + ct * 64 + cc * 8;
    u32x4 o; o.x = cvtpk(acc[0], acc[1]); o.y = cvtpk(acc[2], acc[3]); o.z = cvtpk(acc[4], acc[5]); o.w = cvtpk(acc[6], acc[7]);
    *(u32x4*)dst = o;
    __syncthreads();
}

__device__ __forceinline__ void phase0(const Params& p, LAS unsigned char* lds) {
    const int tid = fresh_tid(), G = gridDim.x, bx = blockIdx.x;
    if (bx == 0 && tid < 16) {
        double inv = 1.0; for (int i = 0; i < tid; ++i) inv *= 0.5623413251903491;
        const double x2 = inv * inv; double term = inv, s = inv, c = 1.0, tc = 1.0;
        for (int k = 1; k <= 12; ++k) { term *= -x2 / (double)((2 * k) * (2 * k + 1)); s += term; tc *= -x2 / (double)((2 * k - 1) * (2 * k)); c += tc; }
        double cc = 1.0, sn = 0.0; float* T = (float*)(p.ws + WS_ROPE);
        for (int pos = 0; pos < 64; ++pos) { T[(pos * 16 + tid) * 2] = (float)cc; T[(pos * 16 + tid) * 2 + 1] = (float)sn; const double nc = cc * c - sn * s; sn = sn * c + cc * s; cc = nc; }
    }
    LAS float* sc = (LAS float*)lds; LAS float* red = sc + 9 * 1024;
    for (int i = tid; i < 9 * 1024; i += 512) { const int b = i >> 10, k = i & 1023; const float v = b < 8 ? p.c[b * 1024 + k] : p.c_ctx[k]; sc[i] = v / (1.0f + __expf(-v)); }
    __syncthreads();
    const int lane = tid & 63, w = tid >> 6;
    float* MOD = (float*)(p.ws + WS_MOD);
    for (int u = bx; u < 4 * 96; u += G) {
        const int l = u / 96, n0 = (u - l * 96) * 64;
        float acc[9];
#pragma unroll
        for (int b = 0; b < 9; ++b) acc[b] = 0.f;
        const float* W = p.w_ada + (size_t)l * 1024 * 6144 + (size_t)(w * 128) * 6144 + n0 + lane;
#pragma unroll 1
        for (int k4 = 0; k4 < 128; k4 += 16) {
            float wq_[16];
#pragma unroll
            for (int i = 0; i < 16; ++i) wq_[i] = W[(size_t)(k4 + i) * 6144];
            __builtin_amdgcn_sched_barrier(0);
#pragma unroll
            for (int i = 0; i < 16; ++i) {
#pragma unroll
                for (int b = 0; b < 9; ++b) acc[b] += sc[b * 1024 + w * 128 + k4 + i] * wq_[i];
            }
        }
#pragma unroll
        for (int b = 0; b < 9; ++b) red[(w * 9 + b) * 64 + lane] = acc[b];
        __syncthreads();
        for (int i = tid; i < 576; i += 512) {
            const int b = i >> 6, ln = i & 63; float s = 0.f;
#pragma unroll
            for (int ww = 0; ww < 8; ++ww) s += red[(ww * 9 + b) * 64 + ln];
            MOD[(size_t)(l * 9 + b) * 6144 + n0 + ln] = s + p.b_ada[l * 6144 + n0 + ln];
        }
        __syncthreads();
    }
}

__device__ __forceinline__ void convert_weights(const Params& p, int l, LAS unsigned char* lds, int vb, int nb) {
    LAS float* scr = (LAS float*)lds;
    const size_t wo = (l & 1) ? WS_WSET1 : 0;
    {
        const int tid = fresh_tid(), lane = tid & 63, w = tid >> 6;
        LAS float* wscr = scr + w * (64 * 33);
        constexpr int T_IN = 16 * 208, T_BR = 8 * 32, T_OUT = 16 * 32, T_1 = 16 * 128, T_2 = 64 * 32, T_ALL = T_IN + 2 * T_BR + T_OUT + T_1 + T_2;
        for (int t = vb * 8 + w; t < T_ALL; t += nb * 8) {
            int r = t;
            if (r < T_IN) { cvt_item(p.w_in + (size_t)l * 1024 * INC, 1024, INC, (bf16_t*)(p.ws + wo + WS_WIN), r, wscr, lane, 1024); continue; } r -= T_IN;
            if (r < T_BR) { cvt_item(p.w_branch + (size_t)(l * 3 + 0) * 512 * 1024, 512, 1024, (bf16_t*)(p.ws + wo + WS_WBR), r, wscr, lane); continue; } r -= T_BR;
            if (r < T_BR) { cvt_item(p.w_branch + (size_t)(l * 3 + 2) * 512 * 1024, 512, 1024, (bf16_t*)(p.ws + wo + WS_WBR) + (size_t)2 * 1024 * 512, r, wscr, lane); continue; } r -= T_BR;
            if (r < T_OUT) { cvt_item(p.w_out + (size_t)l * 1024 * 1024, 1024, 1024, (bf16_t*)(p.ws + wo + WS_WOUT), r, wscr, lane); continue; } r -= T_OUT;
            if (r < T_1) { cvt_item(p.w_mlp1 + (size_t)l * 1024 * DFF, 1024, DFF, (bf16_t*)(p.ws + wo + WS_W1), r, wscr, lane); continue; } r -= T_1;
            cvt_item(p.w_mlp2 + (size_t)l * DFF * 1024, DFF, 1024, (bf16_t*)(p.ws + wo + WS_W2), r, wscr, lane);
        }
        __syncthreads();
    }
    for (int u = vb; u < 128; u += nb) fold_unit(p, l, u, scr, wo);
}
__device__ __forceinline__ void phaseA(const Params& p, int l, LAS unsigned char* lds) {
    if (l == 0) convert_weights(p, 0, lds, (int)blockIdx.x, (int)gridDim.x);
    norm_rows(p, l, MT, p.g_mix + l * 1024, 0, l > 0, l == 0 ? p.x : p.out, l == 0 ? p.ctx : (const float*)(p.ws + WS_XC));
}

__device__ __forceinline__ void phaseC(const Params& p, int l, LAS unsigned char* lds, int vb) {
    const int G = gridDim.x, lane = fresh_tid() & 63;
    const bool last = (l == DEPTH - 1);
    const int n_ctx = last ? 0 : 64;
    const int U1 = 512, U2 = 1024, U3 = U2 + n_ctx, U4 = U3 + n_ctx, U5 = U4 + (last ? ML : MT) / 64;
    for (int u = vb; u < U5; u += G) {
        if (u < U2) {
            const int uu = u & 511;
            const int vu = (G == 256) ? ((uu & 7) * 64 + (uu >> 8) * 32 + ((uu & 255) >> 3)) : uu;
            const int bh = vu >> 4, sub = vu & 15, b = bh >> 2, hq = bh & 3;
            if (u < U1) att::diff_unit(p, l, lds, b, hq, b * 2048 + sub * 128, 36);
            else att::nat_unit(p, l, lds, b, hq, 0, sub);
        } else if (u < U3) {
            const int v = u - U2, b = v >> 3, hq = (v >> 1) & 3, qb = v & 1;
            att::diff_unit(p, l, lds, b, hq, ML + b * 256 + qb * 128, 4);
        } else if (u < U4) {
            const int v = u - U3, b = v >> 3, hq = (v >> 1) & 3, qb = v & 1;
            att::nat_unit(p, l, lds, b, hq, 1, qb);
        } else {
            pool_unit(p, u - U4);
        }
    }
}

__global__ void __launch_bounds__(512, 2) fwd_megakernel(Params p) {
    extern __shared__ __attribute__((aligned(16))) unsigned char smem[];
    LAS unsigned char* lds = (LAS unsigned char*)smem;
    cg::grid_group grid = cg::this_grid();
    const int G = gridDim.x;
    volatile LAS unsigned* bst = (volatile LAS unsigned*)(lds + LDS_BYTES - 256);
    if (fresh_tid() < 2) bst[fresh_tid()] = 0u;
    __syncthreads();
    XcdBarrier bar = xcd_barrier_post((unsigned*)(p.ws + WS_CTL), bst);
    unsigned* cen = (unsigned*)(p.ws + WS_CTL) + 12288;
    if (fresh_tid() == 0) bst[2] = __hip_atomic_fetch_add(cen + bar.x * 16, 1u, __ATOMIC_RELAXED, __HIP_MEMORY_SCOPE_AGENT);
#ifndef ENABLE_MASK
#define ENABLE_MASK 0x3ff
#endif
#define PH_BEGIN(k) if (((ENABLE_MASK) >> (k)) & 1) {
#define PH_END   xcd_barrier(bar); }
#define PH_END0  if (p.ws == nullptr) grid.sync();        \
                 xcd_barrier(bar); }
#define PH_ENDL  }

    PH_BEGIN(0) phase0(p, lds); PH_END0
    if (fresh_tid() == 0) {
        bool even = (G % 8) == 0 && bar.x < 8u;
        for (int j = 0; j < 16; ++j) { const unsigned c_ = __hip_atomic_load(cen + j * 16, __ATOMIC_RELAXED, __HIP_MEMORY_SCOPE_AGENT); even = even && (c_ == (j < 8 ? (unsigned)(G / 8) : 0u)); }
        bst[3] = even ? bst[2] * 8u + bar.x : (unsigned)blockIdx.x;
    }
    __syncthreads();
    const int bx = __builtin_amdgcn_readfirstlane((int)bst[3]);

#pragma unroll 1
    for (int l = 0; l < DEPTH; ++l) {
        const bool last = (l == DEPTH - 1);
        const int Mx = last ? ML : MT;
        const float* MODl = (const float*)(p.ws + WS_MOD) + (size_t)l * 9 * 6144;
        const unsigned char* wsl = p.ws + ((l & 1) ? WS_WSET1 : 0);
        PH_BEGIN(1) phaseA(p, l, lds); PH_END
        PH_BEGIN(2) {
            pg8::Gemm g{(const bf16_t*)(p.ws + WS_HN), (const bf16_t*)(wsl + WS_WIN), MT, INC, DM}; InProjOrder S; S.init(G, bx, last ? 0 : 1);
            EpiInProj E{(bf16_t*)(p.ws + WS_Z1), (bf16_t*)(p.ws + WS_G), (const float*)(p.ws + WS_ROPE), (bf16_t*)(p.ws + WS_KVD), (bf16_t*)(p.ws + WS_KVN)};
            pg8::gemm_phase<EpiInProj, InProjOrder, true, true>(lds, g, S, E);
        } PH_END
        PH_BEGIN(3) phaseC(p, l, lds, bx); PH_END
        PH_BEGIN(4) {
            pg8::Gemm g{(const bf16_t*)(p.ws + WS_A3), (const bf16_t*)(wsl + WS_WBR), 3 * MT, 3 * 1024, 512}; BranchOrder S{last ? 0 : 32, G, bx};
            EpiBranch E{(const bf16_t*)(p.ws + WS_G), (bf16_t*)(p.ws + WS_MB)};
            pg8::gemm_phase<EpiBranch, BranchOrder, true, true>(lds, g, S, E);
            if (!last && G == 256) { if ((bx >> 3) >= 4) convert_weights(p, l + 1, lds, bx - 32, G - 32); }
            else if (!last) convert_weights(p, l + 1, lds, bx, G);
        } PH_END
        PH_BEGIN(5) {
            pg8::Gemm g{(const bf16_t*)(p.ws + WS_MB), (const bf16_t*)(wsl + WS_WOUT), Mx, DM, DM}; SplitOrder S; S.init(G, bx, DM, last ? 0 : 1);
            EpiResid E{l == 0 ? p.x : p.out, p.out, (float*)(p.ws + WS_PART), MODl, 2};
            pg8::gemm_phase<EpiResid, SplitOrder, true, true>(lds, g, S, E);
        } PH_END
        PH_BEGIN(6) norm_rows(p, l, Mx, p.g_mlp + l * 1024, 3, !last, p.out, l == 0 ? p.ctx : (const float*)(p.ws + WS_XC)); PH_END
        PH_BEGIN(7) {
            pg8::Gemm g{(const bf16_t*)(p.ws + WS_HN), (const bf16_t*)(wsl + WS_W1), Mx, DFF, DM}; pg8::StaticOrder S; S.init(Mx, DFF, G, bx, DM);
            EpiMlp1 E{(bf16_t*)(p.ws + WS_H)};
            pg8::gemm_phase<EpiMlp1, pg8::StaticOrder, true, true>(lds, g, S, E);
        } PH_END
        PH_BEGIN(8) {
            pg8::Gemm g{(const bf16_t*)(p.ws + WS_H), (const bf16_t*)(wsl + WS_W2), Mx, DM, DFF}; SplitOrder S; S.init(G, bx, DFF, last ? 0 : 1);
            EpiResid E{p.out, p.out, (float*)(p.ws + WS_PART), MODl, 5};
            pg8::gemm_phase<EpiResid, SplitOrder, true, true>(lds, g, S, E);
        } PH_END
    }
    PH_BEGIN(9) final_norm(p); PH_ENDL
#undef PH_BEGIN
#undef PH_END
#undef PH_END0
#undef PH_ENDL
}

#ifndef MK_MULTI
#define MK_MULTI 0
#endif
extern "C" void kernel_launch(void* const* d_in, const int* in_sizes, int n_in, void* d_out, int out_size, void* d_ws, size_t ws_size, hipStream_t stream) {
    static int grid_blocks = 0;
    if (grid_blocks == 0) {
        if (n_in != 22 || ws_size < WS_END) { fprintf(stderr, "kernel_launch: unexpected n_in %d / ws_size %zu (need %zu)\n", n_in, ws_size, (size_t)WS_END); grid_blocks = -1; return; }
        int dev = 0, cus = 0, per_cu = 0;
        hipGetDevice(&dev);
        hipDeviceGetAttribute(&cus, hipDeviceAttributeMultiprocessorCount, dev);
        if (hipFuncSetAttribute((const void*)fwd_megakernel, hipFuncAttributeMaxDynamicSharedMemorySize, LDS_BYTES) != hipSuccess) fprintf(stderr, "kernel_launch: hipFuncSetAttribute failed\n");
        hipOccupancyMaxActiveBlocksPerMultiprocessor(&per_cu, (const void*)fwd_megakernel, 512, LDS_BYTES);
        (void)hipGetLastError();
        if (per_cu < 1) { fprintf(stderr, "kernel_launch: occupancy query returned %d\n", per_cu); per_cu = 1; }
        grid_blocks = cus * per_cu;
    }
    if (grid_blocks < 0) return;
    if (hipMemsetAsync((char*)d_ws + WS_CTL, 0, 65536, stream) != hipSuccess) fprintf(stderr, "kernel_launch: memset failed\n");
    Params p{};
    const float** f = (const float**)&p;
    for (int i = 0; i < 22; ++i) f[i] = (const float*)d_in[i];
    p.out = (float*)d_out; p.ws = (unsigned char*)d_ws;
    void* args[] = {&p};
    hipError_t e = hipLaunchCooperativeKernel((const void*)fwd_megakernel, dim3(grid_blocks), dim3(512), args, LDS_BYTES, stream);
    if (e != hipSuccess) fprintf(stderr, "cooperative launch failed: %s (grid %d)\n", hipGetErrorString(e), grid_blocks);
}
```

```cpp
#include <hip/hip_runtime.h>
#include <hip/hip_cooperative_groups.h>
#include <cstdio>
#include <cstdint>
namespace cg = cooperative_groups;
__device__ __forceinline__ int fresh_tid() { int t = (int)threadIdx.x; asm volatile("" : "+v"(t)); return t; }
namespace pg8 {
#define PG8_LAS __attribute__((address_space(3)))
typedef unsigned short bf16_t;
typedef short bf16x8 __attribute__((ext_vector_type(8)));
typedef float f32x4 __attribute__((ext_vector_type(4)));
typedef unsigned u32x4 __attribute__((ext_vector_type(4)));
constexpr int BM = 256, BK = 64, HALF = 128, HTB = HALF * BK * 2  , STAGE_BYTES = 8 * HTB, NXCD = 8, WGM = 8;

__host__ __device__ __forceinline__ int lds_byte(int r, int c) { const int st = (r >> 4) * 2 + (c >> 5), rr = r & 15, cc = c & 31, ob = rr * 64 + cc * 2; return st * 1024 + (ob ^ (((ob >> 9) & 1) << 5)); }
__host__ __device__ __forceinline__ void stage_rc(int b, int& R, int& C) { const int st = b / 1024, sb = b % 1024, swz = sb ^ (((sb >> 9) & 1) << 5); R = (st >> 1) * 16 + swz / 64; C = (st & 1) * 32 + (swz % 64) / 2; }
__host__ __device__ __forceinline__ int perm32(int rho) { const int n = rho >> 4, i = rho & 15; return 8 * (i >> 2) + 4 * n + (i & 3); }

struct Unit { int pm, pn, koff, nt, ks; };
struct Gemm { const bf16_t* A; const bf16_t* Bt; int M, N, K; };

struct StaticOrder {
    int nM, nN, nwg, G, c, ntf;
    __host__ __device__ __forceinline__ void init(int M, int N, int G_, int c_, int K_) { nM = M / BM; nN = N / BM; nwg = nM * nN; G = G_; c = c_; ntf = K_ / BK; }
    __host__ __device__ __forceinline__ bool next(int i, Unit& u) const {
        const long L = (long)i * G + c; if (L >= nwg) return false;
        int wgid = (int)L; { const int q = nwg / NXCD, r = nwg % NXCD, xcd = wgid % NXCD, off = wgid / NXCD; wgid = (xcd < r ? xcd * (q + 1) : r * (q + 1) + (xcd - r) * q) + off; }
        const int nig = WGM * nN, gid = wgid / nig, fm = gid * WGM, gsz = (nM - fm) < WGM ? (nM - fm) : WGM;
        u.pm = fm + ((wgid % nig) % gsz); u.pn = (wgid % nig) / gsz; u.koff = 0; u.nt = ntf; u.ks = 0; return true;
    }
    __device__ __forceinline__ void a_ready(const Unit&) const {}
    __device__ __forceinline__ void done(const Unit&) const {}
};

template <class Epi, class Sched, bool ALIGN_EPI = false, bool SP2 = false>
__device__ __forceinline__ void gemm_phase(PG8_LAS unsigned char* lds, const Gemm g, const Sched& S, const Epi& E) {
    const int tid = fresh_tid(), wid = __builtin_amdgcn_readfirstlane(tid >> 6), lane = tid & 63, wr = wid >> 2, wc = wid & 3, fr = lane & 15, fq = lane >> 4;
    const int K = g.K;
    unsigned voffA[2], voffB[2];
#pragma unroll
    for (int i = 0; i < 2; ++i) { int R, C; stage_rc(tid * 16 + i * 8192, R, C); const int Rb = Epi::PERM ? ((R & ~31) + perm32(R & 31)) : R;
        voffA[i] = (unsigned)(R * K + C) * 2u; voffB[i] = (unsigned)(Rb * K + C) * 2u; }
    const size_t kstep = (size_t)(BK * 2);
    const size_t hstep = (size_t)HALF * K * 2;
    const size_t tstep = 2 * hstep;
    const unsigned ldsw = (unsigned)wid * 1024u;
    const int aoff = lds_byte(wr * 64 + fr, fq * 8), boff = lds_byte(wc * 32 + fr, fq * 8);
#define PG8_SA(b, h) (((b) * 2 + (h)) * HTB)
#define PG8_SB(b, h) ((4 + (b) * 2 + (h)) * HTB)
#define PG8_STAGE(bufoff, gbase, voff) do { _Pragma("unroll") for (int _i = 0; _i < 2; ++_i) \
        __builtin_amdgcn_global_load_lds((const unsigned*)((const char*)(gbase) + (voff)[_i]), (PG8_LAS unsigned*)(lds + (bufoff) + ldsw + _i * 8192), 16, 0, 0); } while (0)
#define PG8_LDA(dst, b, h) do { _Pragma("unroll") for (int m = 0; m < 4; ++m) _Pragma("unroll") for (int k = 0; k < 2; ++k) dst[m][k] = *(const PG8_LAS bf16x8*)(lds + PG8_SA(b, h) + aoff + m * 2048 + k * 1024); } while (0)
#define PG8_LDB(dst, b, h) do { _Pragma("unroll") for (int n = 0; n < 2; ++n) _Pragma("unroll") for (int k = 0; k < 2; ++k) dst[n][k] = *(const PG8_LAS bf16x8*)(lds + PG8_SB(b, h) + boff + n * 2048 + k * 1024); } while (0)
#define PG8_MMA(ai, bj, At, Bt) do { __builtin_amdgcn_s_setprio(1); _Pragma("unroll") for (int m = 0; m < 4; ++m) _Pragma("unroll") for (int n = 0; n < 2; ++n) _Pragma("unroll") for (int k = 0; k < 2; ++k) \
        acc[ai][bj][m][n] = __builtin_amdgcn_mfma_f32_16x16x32_bf16(Bt[n][k], At[m][k], acc[ai][bj][m][n], 0, 0, 0); __builtin_amdgcn_s_setprio(0); } while (0)
#define PG8_WAIT_V(n) asm volatile("s_waitcnt vmcnt(" #n ")" ::: "memory")
#define PG8_WAIT_L(n) asm volatile("s_waitcnt lgkmcnt(" #n ")" ::: "memory")
#define PG8_BAR __builtin_amdgcn_s_barrier()
#define PG8_SCHED __builtin_amdgcn_sched_barrier(0)
    Unit cur, nxt; int ui = 0;
    if (!S.next(0, cur)) return;
    f32x4 acc[2][2][4][2];
#pragma unroll
    for (int a = 0; a < 2; ++a)
#pragma unroll
        for (int b = 0; b < 2; ++b)
#pragma unroll
            for (int m = 0; m < 4; ++m)
#pragma unroll
                for (int n = 0; n < 2; ++n) acc[a][b][m][n] = (f32x4){0.f, 0.f, 0.f, 0.f};
    bf16x8 At[4][2], B0[2][2], B1[2][2];
    const char* cA = (const char*)g.A + (size_t)cur.pm * tstep + cur.koff; const char* cB = (const char*)g.Bt + (size_t)cur.pn * tstep + cur.koff;
    S.a_ready(cur);
    if constexpr (SP2) {
        PG8_STAGE(PG8_SB(0, 0), cB, voffB); PG8_STAGE(PG8_SB(0, 1), cB + hstep, voffB); PG8_STAGE(PG8_SA(0, 0), cA, voffA); PG8_STAGE(PG8_SA(0, 1), cA + hstep, voffA);
        if (wr == 1) PG8_BAR;
        PG8_WAIT_V(2); PG8_BAR;
        PG8_STAGE(PG8_SB(1, 0), cB + kstep, voffB); PG8_STAGE(PG8_SA(1, 0), cA + kstep, voffA); PG8_STAGE(PG8_SB(1, 1), cB + hstep + kstep, voffB);
        PG8_WAIT_V(6); PG8_BAR;
    } else {
        PG8_STAGE(PG8_SB(0, 0), cB, voffB); PG8_STAGE(PG8_SA(0, 0), cA, voffA); PG8_STAGE(PG8_SB(0, 1), cB + hstep, voffB); PG8_STAGE(PG8_SA(0, 1), cA + hstep, voffA);
        if (wr == 1) PG8_BAR;
        PG8_WAIT_V(4); PG8_BAR;
        PG8_STAGE(PG8_SB(1, 0), cB + kstep, voffB); PG8_STAGE(PG8_SA(1, 0), cA + kstep, voffA); PG8_STAGE(PG8_SB(1, 1), cB + hstep + kstep, voffB);
        PG8_WAIT_V(6); PG8_BAR;
    }
    for (;;) {
        const bool has_next = S.next(ui + 1, nxt);
        const char* nA = has_next ? (const char*)g.A + (size_t)nxt.pm * tstep + nxt.koff : cA; const char* nB = has_next ? (const char*)g.Bt + (size_t)nxt.pn * tstep + nxt.koff : cB;
        const int nt = cur.nt;
        for (int t = 0; t < nt; t += 2) {
            const bool last = (t == nt - 2);
            const char* a1 = cA + (size_t)(t + 1) * kstep;
            const char* a2 = last ? nA : cA + (size_t)(t + 2) * kstep; const char* b2 = last ? nB : cB + (size_t)(t + 2) * kstep;
            const char* a3 = a2 + kstep; const char* b3 = b2 + kstep;
            if (last && has_next) S.a_ready(nxt);
            if constexpr (SP2) {
            PG8_LDB(B0, 0, 0); PG8_LDB(B1, 0, 1); PG8_SCHED; PG8_LDA(At, 0, 0); PG8_STAGE(PG8_SA(1, 1), a1 + hstep, voffA);
            PG8_WAIT_V(8); PG8_WAIT_L(0); PG8_BAR; PG8_MMA(0, 0, At, B0); PG8_MMA(0, 1, At, B1); PG8_BAR; PG8_SCHED;
            PG8_LDA(At, 0, 1); PG8_STAGE(PG8_SB(0, 0), b2, voffB); PG8_STAGE(PG8_SB(0, 1), b2 + hstep, voffB); PG8_STAGE(PG8_SA(0, 0), a2, voffA);
            PG8_WAIT_V(8); PG8_WAIT_L(0); PG8_BAR; PG8_MMA(1, 0, At, B0); PG8_MMA(1, 1, At, B1); PG8_BAR; PG8_SCHED;
            PG8_LDB(B0, 1, 0); PG8_LDB(B1, 1, 1); PG8_SCHED; PG8_LDA(At, 1, 0); PG8_STAGE(PG8_SA(0, 1), a2 + hstep, voffA);
            PG8_WAIT_V(8); PG8_WAIT_L(0); PG8_BAR; PG8_MMA(0, 0, At, B0); PG8_MMA(0, 1, At, B1); PG8_BAR; PG8_SCHED;
            PG8_LDA(At, 1, 1); PG8_STAGE(PG8_SB(1, 0), b3, voffB); PG8_STAGE(PG8_SB(1, 1), b3 + hstep, voffB); PG8_STAGE(PG8_SA(1, 0), a3, voffA);
            PG8_WAIT_V(8); PG8_WAIT_L(0); PG8_BAR; PG8_MMA(1, 0, At, B0); PG8_MMA(1, 1, At, B1); PG8_BAR; PG8_SCHED;
            } else {
            PG8_LDB(B0, 0, 0); PG8_SCHED; PG8_LDA(At, 0, 0); PG8_STAGE(PG8_SA(1, 1), a1 + hstep, voffA);
            PG8_WAIT_L(8); PG8_BAR; PG8_WAIT_L(0); PG8_MMA(0, 0, At, B0); PG8_BAR; PG8_SCHED;
            PG8_LDB(B1, 0, 1); PG8_STAGE(PG8_SB(0, 0), b2, voffB);
            PG8_BAR; PG8_WAIT_L(0); PG8_MMA(0, 1, At, B1); PG8_BAR;
            PG8_LDA(At, 0, 1); PG8_STAGE(PG8_SA(0, 0), a2, voffA);
            PG8_BAR; PG8_WAIT_L(0); PG8_MMA(1, 0, At, B0); PG8_BAR; PG8_SCHED;
            PG8_STAGE(PG8_SB(0, 1), b2 + hstep, voffB);
            PG8_WAIT_V(6); PG8_BAR; PG8_MMA(1, 1, At, B1); PG8_BAR;
            PG8_LDB(B0, 1, 0); PG8_SCHED; PG8_LDA(At, 1, 0); PG8_STAGE(PG8_SA(0, 1), a2 + hstep, voffA);
            PG8_WAIT_L(8); PG8_BAR; PG8_WAIT_L(0); PG8_MMA(0, 0, At, B0); PG8_BAR; PG8_SCHED;
            PG8_LDB(B1, 1, 1); PG8_STAGE(PG8_SB(1, 0), b3, voffB);
            PG8_BAR; PG8_WAIT_L(0); PG8_MMA(0, 1, At, B1); PG8_BAR;
            PG8_LDA(At, 1, 1); PG8_STAGE(PG8_SA(1, 0), a3, voffA);
            PG8_BAR; PG8_WAIT_L(0); PG8_MMA(1, 0, At, B0); PG8_BAR; PG8_SCHED;
            PG8_STAGE(PG8_SB(1, 1), b3 + hstep, voffB);
            PG8_WAIT_V(6); PG8_BAR; PG8_MMA(1, 1, At, B1); PG8_BAR;
            }
        }
        if constexpr (ALIGN_EPI) { if (wr == 0) PG8_BAR; }
        if constexpr (!Epi::AFTER_DRAIN) { E(acc, cur, wr, wc, fr, fq); S.done(cur); }
        if (!has_next) break;
        if (!Epi::keep_acc(nxt)) {
#pragma unroll
        for (int a = 0; a < 2; ++a)
#pragma unroll
            for (int b = 0; b < 2; ++b)
#pragma unroll
                for (int m = 0; m < 4; ++m)
#pragma unroll
                    for (int n = 0; n < 2; ++n) acc[a][b][m][n] = (f32x4){0.f, 0.f, 0.f, 0.f};
        }
        cur = nxt; cA = nA; cB = nB; ++ui;
        if constexpr (ALIGN_EPI) { if (wr == 1) PG8_BAR; }
    }
    PG8_WAIT_V(0);
    if constexpr (!ALIGN_EPI) { if (wr == 0) PG8_BAR; }
    PG8_BAR;
    if constexpr (Epi::AFTER_DRAIN) { E.fused(acc, cur, wr, wc, fr, fq, lds, wid, lane); S.done(cur); }
#undef PG8_SA
#undef PG8_SB
#undef PG8_STAGE
#undef PG8_LDA
#undef PG8_LDB
#undef PG8_MMA
#undef PG8_WAIT_V
#undef PG8_WAIT_L
#undef PG8_BAR
#undef PG8_SCHED
}
}

#define LAS __attribute__((address_space(3)))
typedef unsigned short bf16_t;
typedef short bf16x8 __attribute__((ext_vector_type(8)));
typedef short s16x4 __attribute__((ext_vector_type(4)));
typedef float f32x4 __attribute__((ext_vector_type(4)));
typedef float f32x16 __attribute__((ext_vector_type(16)));
typedef unsigned u32x4 __attribute__((ext_vector_type(4)));
typedef unsigned u32x2 __attribute__((ext_vector_type(2)));
typedef float f32x2_t __attribute__((ext_vector_type(2)));
typedef __bf16 bf16x2_t __attribute__((ext_vector_type(2)));

constexpr int DM = 1024, NBATCH = 8, SEQ = 2048, DEPTH = 4, CTXL = 256;
constexpr int ML = NBATCH * SEQ, MC = NBATCH * CTXL, MT = ML + MC;
constexpr int INC = 6656, ZC = 1536, GCOLS = 3072, DFF = 4096;
constexpr int KVT = 2304, KVROW = 256;
constexpr int NMT = MT / 256;
constexpr size_t MiB = (size_t)1 << 20;
constexpr size_t WS_WIN = 0, WS_WBR = 13 * MiB, WS_WOUT = 16 * MiB, WS_W1 = 18 * MiB, WS_W2 = 26 * MiB, WS_XC = 34 * MiB,
                 WS_MOD = 42 * MiB, WS_ROPE = 43 * MiB, WS_CTL = 43 * MiB + 512 * 1024, WS_A3 = 44 * MiB, WS_Z1 = 98 * MiB, WS_G = 224 * MiB, WS_PART = 332 * MiB, WS_WSET1 = 396 * MiB, WS_END = 430 * MiB;
constexpr size_t WS_HN = WS_A3, WS_KVD = WS_Z1 + 54 * MiB, WS_KVN = WS_Z1 + 90 * MiB, WS_MB = WS_Z1 + 72 * MiB, WS_H = WS_Z1;
constexpr int LDS_BYTES = 155648;
constexpr float LOG2E = 1.4426950408889634f;

struct Params {
    const float *x, *c, *ctx, *c_ctx, *w_ada, *b_ada, *g_mix, *g_mlp, *w_in, *lq1, *lk1, *lq2, *lk2, *g_subln, *pool_w, *pool_scale,
                *nat_rpb, *w_branch, *w_out, *w_mlp1, *w_mlp2, *g_final;
    float* out; unsigned char* ws;
};

__device__ __forceinline__ unsigned cvtpk(float lo, float hi) { f32x2_t v = {lo, hi}; bf16x2_t b = __builtin_convertvector(v, bf16x2_t); return __builtin_bit_cast(unsigned, b); }
__device__ __forceinline__ float bf2f(unsigned short v) { return __uint_as_float((unsigned)v << 16); }
__device__ __forceinline__ float wave_sum(float v) {
#pragma unroll
    for (int o = 1; o < 64; o <<= 1) v += __shfl_xor(v, o);
    return v;
}
__device__ __forceinline__ float* xrow_ptr(const Params& p, int row) { return row < ML ? p.out + (size_t)row * DM : (float*)(p.ws + WS_XC) + (size_t)(row - ML) * DM; }

#define XB_TMO      128
#define XB_XCNT(j)  (256  + 64 * (j))
#define XB_XSUB(j)  (1280 + 64 * (j))
#define XB_XGEN(j)  (2304 + 64 * (j))
#define XB_TOP      3328
#define XB_TOPGEN   3392
#define XCD_BAR_WORDS 3456
#define XB_SPIN_CAP (1u << 18)

__device__ __forceinline__ unsigned xb_ld(unsigned* p)              { return __hip_atomic_load(p, __ATOMIC_RELAXED, __HIP_MEMORY_SCOPE_AGENT); }
__device__ __forceinline__ unsigned xb_add(unsigned* p, unsigned v) { return __hip_atomic_fetch_add(p, v, __ATOMIC_RELAXED, __HIP_MEMORY_SCOPE_AGENT); }
__device__ __forceinline__ unsigned xb_xcc_id() { return (unsigned)__builtin_amdgcn_s_getreg((3 << 11) | 20) & 0xFu; }
#define XB_SPIN(cond, bar) do { unsigned _sp = 0; while (cond) { __builtin_amdgcn_s_sleep(1); \
    if ((++_sp & 255u) == 0u) { if (xb_ld(&(bar)[XB_TMO])) break; if (_sp > XB_SPIN_CAP) { atomicAdd(&(bar)[XB_TMO], 1u); break; } } } } while (0)

struct XcdBarrier {
    unsigned* bar; unsigned x;
    volatile LAS unsigned* st;
};

__device__ __forceinline__ XcdBarrier xcd_barrier_post(unsigned* bar, volatile LAS unsigned* st) {
    XcdBarrier b; b.bar = bar; b.x = xb_xcc_id(); b.st = st;
    if (threadIdx.x == 0) (void)xb_add(&bar[XB_XCNT(b.x)], 1u);
    return b;
}
__device__ __forceinline__ void xcd_barrier_complete(unsigned* bar, unsigned x, unsigned& nloc, unsigned& nx) {
    const unsigned G = gridDim.x * gridDim.y * gridDim.z;
    unsigned sum, cnt, mine, sp = 0u;
    for (;;) {
        sum = 0u; cnt = 0u; mine = 0u;
#pragma unroll
        for (unsigned j = 0; j < 16; ++j) { const unsigned c = xb_ld(&bar[XB_XCNT(j)]); sum += c; cnt += (c > 0u) ? 1u : 0u; mine = (j == x) ? c : mine; }
        if (sum == G) break;
        __builtin_amdgcn_s_sleep(1);
        if ((++sp & 255u) == 0u) { if (xb_ld(&bar[XB_TMO])) break; if (sp > XB_SPIN_CAP) { atomicAdd(&bar[XB_TMO], 1u); break; } }
    }
    nloc = mine > 0u ? mine : 1u; nx = cnt > 0u ? cnt : 1u;
}

__device__ __forceinline__ void xcd_barrier(const XcdBarrier& b) {
    asm volatile("s_waitcnt vmcnt(0)" ::: "memory");
    __syncthreads();
    if (threadIdx.x == 0) {
        unsigned* bar = b.bar;
        __builtin_amdgcn_s_waitcnt(0);
        unsigned nloc = b.st[0], nx = b.st[1];
        if (nloc == 0u) { xcd_barrier_complete(bar, b.x, nloc, nx); b.st[0] = nloc; b.st[1] = nx; }
        const unsigned old = xb_add(&bar[XB_XSUB(b.x)], 1u);
        const unsigned gen = old / nloc;
        if (old + 1u == (gen + 1u) * nloc) {
            __builtin_amdgcn_fence(__ATOMIC_RELEASE, "agent");
            asm volatile("s_waitcnt vmcnt(0)" ::: "memory");
            const unsigned og = xb_add(&bar[XB_TOP], 1u);
            const unsigned tg = og / nx;
            if (og + 1u == (tg + 1u) * nx) xb_add(&bar[XB_TOPGEN], 1u);
            else XB_SPIN(xb_ld(&bar[XB_TOPGEN]) == tg, bar);
            __builtin_amdgcn_fence(__ATOMIC_ACQUIRE, "agent");
            xb_add(&bar[XB_XGEN(b.x)], 1u);
            asm volatile("s_waitcnt vmcnt(0)" ::: "memory");
        } else {
            XB_SPIN(xb_ld(&bar[XB_XGEN(b.x)]) == gen, bar);
            __builtin_amdgcn_fence(__ATOMIC_ACQUIRE, "agent");
            asm volatile("s_waitcnt vmcnt(0)" ::: "memory");
        }
    }
    __syncthreads();
}

struct EpiInProj {
    static constexpr bool PERM = true, AFTER_DRAIN = false;
    static __device__ __forceinline__ bool keep_acc(const pg8::Unit&) { return false; }
    bf16_t* Z1; bf16_t* G; const float* rope; bf16_t* KVD; bf16_t* KVN;
    __device__ __forceinline__ void operator()(const f32x4 (&acc)[2][2][4][2], const pg8::Unit& u, int wr, int wc, int fr, int fq) const {
        const int pn = u.pn;
        if (pn < 14) {
            const bool rope_tile = pn < 4;
            const int kind = pn >> 1;
            const bool tokmajor = (kind == 0) || (kind == 3) || (kind == 4);
            const int zoff = (kind == 0 ? 0 : kind == 3 ? 512 : 1024) + (pn & 1) * 256;
            bf16_t* kvb = (kind <= 2 ? KVD : KVN) + ((kind == 2 || kind == 6) ? 128 : 0);
            f32x4 csq[16];
#pragma unroll
            for (int k = 0; k < 8; ++k) {
                const int row = u.pm * 256 + (k >> 2) * 128 + wr * 64 + (k & 3) * 16 + fr;
                if (rope_tile && row < ML) {
                    const int pos = (wc & 1) ? (row & 63) : ((row >> 6) & 31);
                    const f32x4* t = (const f32x4*)(rope + pos * 32 + fq * 8);
                    csq[2 * k] = t[0]; csq[2 * k + 1] = t[1];
                } else { csq[2 * k] = (f32x4){1.f, 0.f, 1.f, 0.f}; csq[2 * k + 1] = (f32x4){1.f, 0.f, 1.f, 0.f}; }
            }
            __builtin_amdgcn_sched_barrier(0);
#pragma unroll
            for (int ai = 0; ai < 2; ++ai)
#pragma unroll
                for (int m = 0; m < 4; ++m) {
                    const int row = u.pm * 256 + ai * 128 + wr * 64 + m * 16 + fr;
                    const f32x4 cs0 = csq[2 * (ai * 4 + m)], cs1 = csq[2 * (ai * 4 + m) + 1];
                    const int bb = row < ML ? (row >> 11) : ((row - ML) >> 8), tt = row < ML ? 256 + (row & 2047) : ((row - ML) & 255);
                    bf16_t* rp = tokmajor ? Z1 + (size_t)row * ZC + zoff + wc * 32 + fq * 8
                                          : kvb + ((size_t)(bb * 4 + (pn & 1) * 2) * KVT + tt) * KVROW + wc * 32 + fq * 8;
                    const size_t bjs = tokmajor ? (size_t)128 : (size_t)KVT * KVROW;
#pragma unroll
                    for (int bj = 0; bj < 2; ++bj) {
                        const f32x4 u1 = acc[ai][bj][m][0], u2 = acc[ai][bj][m][1];
                        f32x4 n1, n2;
                        n1[0] = u1[0] * cs0[0] - u2[0] * cs0[1]; n2[0] = u1[0] * cs0[1] + u2[0] * cs0[0];
                        n1[1] = u1[1] * cs0[2] - u2[1] * cs0[3]; n2[1] = u1[1] * cs0[3] + u2[1] * cs0[2];
                        n1[2] = u1[2] * cs1[0] - u2[2] * cs1[1]; n2[2] = u1[2] * cs1[1] + u2[2] * cs1[0];
                        n1[3] = u1[3] * cs1[2] - u2[3] * cs1[3]; n2[3] = u1[3] * cs1[3] + u2[3] * cs1[2];
                        u32x4 w_; w_.x = cvtpk(n1[0], n1[1]); w_.y = cvtpk(n1[2], n1[3]); w_.z = cvtpk(n2[0], n2[1]); w_.w = cvtpk(n2[2], n2[3]);
                        *(u32x4*)(rp + bj * bjs) = w_;
                    }
                }
        } else {
            const int sub = (pn - 14) >> 2, pn4 = (pn - 14) & 3;
            bf16_t* gp = G + ((((size_t)(sub * NMT + u.pm) * 4 + pn4) * 8 + (wr * 4 + wc)) * 64 + (fq * 16 + fr)) * 128;
#pragma unroll
            for (int ai = 0; ai < 2; ++ai)
#pragma unroll
                for (int m = 0; m < 4; ++m)
#pragma unroll
                    for (int bj = 0; bj < 2; ++bj) {
                        f32x4 s0v, s1v; const f32x4 v0 = acc[ai][bj][m][0], v1 = acc[ai][bj][m][1];
#pragma unroll
                        for (int e = 0; e < 4; ++e) { s0v[e] = __builtin_amdgcn_rcpf(1.0f + __expf(-v0[e])); s1v[e] = __builtin_amdgcn_rcpf(1.0f + __expf(-v1[e])); }
                        u32x4 w; w.x = cvtpk(s0v[0], s0v[1]); w.y = cvtpk(s0v[2], s0v[3]); w.z = cvtpk(s1v[0], s1v[1]); w.w = cvtpk(s1v[2], s1v[3]);
                        *(u32x4*)(gp + ((ai * 4 + m) * 2 + bj) * 8) = w;
                    }
        }
    }
};

struct EpiBranch {
    static constexpr bool PERM = true, AFTER_DRAIN = false;
    static __device__ __forceinline__ bool keep_acc(const pg8::Unit& nxt) { return (nxt.pn >> 2) != 0; }
    const bf16_t* G; bf16_t* MB;
    __device__ __forceinline__ void operator()(f32x4 (&acc)[2][2][4][2], const pg8::Unit& u, int wr, int wc, int fr, int fq) const {
        const int sub = u.pn >> 2, pn = u.pn & 3, pm = u.pm - sub * NMT;
        constexpr size_t SUBSTRIDE = (size_t)NMT * 4 * 8 * 64 * 128;
        const bf16_t* gp = G + ((((size_t)(sub * NMT + pm) * 4 + pn) * 8 + (wr * 4 + wc)) * 64 + (fq * 16 + fr)) * 128;
#define UNPK_LO(w) __uint_as_float((w) << 16)
#define UNPK_HI(w) __uint_as_float((w) & 0xffff0000u)
#pragma unroll
        for (int ai = 0; ai < 2; ++ai) {
            u32x4 gw[8], hw[8];
#pragma unroll
            for (int k = 0; k < 8; ++k) gw[k] = *(const u32x4*)(gp + (ai * 8 + k) * 8);
            if (sub < 2) {
#pragma unroll
                for (int k = 0; k < 8; ++k) hw[k] = *(const u32x4*)(gp + SUBSTRIDE + (ai * 8 + k) * 8);
            }
            __builtin_amdgcn_sched_barrier(0);
#pragma unroll
            for (int m = 0; m < 4; ++m)
#pragma unroll
                for (int bj = 0; bj < 2; ++bj) {
                    const u32x4 g_ = gw[m * 2 + bj];
                    f32x4 g0 = {UNPK_LO(g_.x), UNPK_HI(g_.x), UNPK_LO(g_.y), UNPK_HI(g_.y)}, g1 = {UNPK_LO(g_.z), UNPK_HI(g_.z), UNPK_LO(g_.w), UNPK_HI(g_.w)};
                    if (sub < 2) {
                        const u32x4 h_ = hw[m * 2 + bj];
                        const f32x4 h0 = {UNPK_LO(h_.x), UNPK_HI(h_.x), UNPK_LO(h_.y), UNPK_HI(h_.y)}, h1 = {UNPK_LO(h_.z), UNPK_HI(h_.z), UNPK_LO(h_.w), UNPK_HI(h_.w)};
#pragma unroll
                        for (int e2 = 0; e2 < 4; ++e2) { acc[ai][bj][m][0][e2] *= g0[e2] * __builtin_amdgcn_rcpf(h0[e2]); acc[ai][bj][m][1][e2] *= g1[e2] * __builtin_amdgcn_rcpf(h1[e2]); }
                    } else {
                        const int row = pm * 256 + ai * 128 + wr * 64 + m * 16 + fr, col0 = pn * 256 + wc * 32 + fq * 8;
                        const f32x4 v0 = acc[ai][bj][m][0] * g0, v1 = acc[ai][bj][m][1] * g1;
                        u32x4 w_; w_.x = cvtpk(v0[0], v0[1]); w_.y = cvtpk(v0[2], v0[3]); w_.z = cvtpk(v1[0], v1[1]); w_.w = cvtpk(v1[2], v1[3]);
                        *(u32x4*)(MB + (size_t)row * DM + col0 + bj * 128) = w_;
                    }
                }
            __builtin_amdgcn_sched_barrier(0);
        }
#undef UNPK_LO
#undef UNPK_HI
    }
};
struct BranchOrder {
    int nctx_tiles, G, c;
    __device__ __forceinline__ bool next(int i, pg8::Unit& u) const {
        const int t = i / 3, sub = i - 3 * t, x = c & 7, sl = c >> 3;
        bool ok; int pm, pn;
        if (G == 256) { ok = (t == 0) || (t == 1 && nctx_tiles > 0 && sl < 4); pm = t == 0 ? x + 8 * (sl >> 2) : 64 + x; pn = sl & 3; }
        else { const long L = (long)t * G + c; ok = L < 256 + nctx_tiles; pm = (int)(L >> 2); pn = (int)(L & 3); }
        u.pm = sub * NMT + pm; u.pn = sub * 4 + pn; u.koff = 0; u.nt = 8; u.ks = 0; return ok;
    }
    __device__ __forceinline__ void a_ready(const pg8::Unit&) const {}
    __device__ __forceinline__ void done(const pg8::Unit&) const {}
};

struct InProjOrder {
    pg8::StaticOrder lat, ctxo; int G, c, full;
    __device__ __forceinline__ void init(int G_, int c_, int full_) { lat.init(ML, INC, G_, c_, DM); ctxo.init(MC, INC, G_, c_, DM); G = G_; c = c_; full = full_; }
    __device__ __forceinline__ bool next(int i, pg8::Unit& u) const {
        const long L = (long)i * G + c;
        const int nlat = 64 * 26;
        pg8::Unit a; a.pm = 0; a.pn = 0; a.koff = 0; a.nt = 16; a.ks = 0;
        const bool islat = L < nlat;
        (void)lat.next(islat ? i : 0, a);
        const int k = (int)(L - nlat);
        const int nctx = full ? 8 * 26 : 8 * 8;
        int cpm, cpn;
        if (full) { cpm = k / 26; cpn = k - cpm * 26; } else { cpm = k >> 3; const int t = k & 7; cpn = t < 4 ? 2 + t : 6 + t; }
        u.pm = islat ? a.pm : 64 + cpm; u.pn = islat ? a.pn : cpn; u.koff = 0; u.nt = 16; u.ks = 0;
        return islat ? true : (k < nctx);
    }
    __device__ __forceinline__ void a_ready(const pg8::Unit&) const {}
    __device__ __forceinline__ void done(const pg8::Unit&) const {}
};

struct SplitOrder {
    pg8::StaticOrder lat; int G, c, nlat, K, split;
    __device__ __forceinline__ void init(int G_, int c_, int K_, int split_) { lat.init(ML, DM, G_, c_, K_); G = G_; c = c_; K = K_; split = split_; nlat = c_ < 256 ? (256 - c_ + G_ - 1) / G_ : 0; }
    __device__ __forceinline__ bool next(int i, pg8::Unit& u) const {
        const bool islat = i < nlat;
        pg8::Unit a; a.pm = 0; a.pn = 0; a.koff = 0; a.nt = 2; a.ks = 0;
        const bool oka = lat.next(islat ? i : 0, a);
        const int q = (i - nlat) * G + c, unit = q >> 3, ks = q & 7;
        const bool okp = split && q < 256;
        u.pm = islat ? a.pm : 64 + (unit >> 2); u.pn = islat ? a.pn : (unit & 3); u.nt = islat ? a.nt : K / 512; u.koff = islat ? 0 : ks * (K / 8) * 2; u.ks = islat ? 0 : ks;
        return islat ? oka : okp;
    }
    __device__ __forceinline__ void a_ready(const pg8::Unit&) const {}
    __device__ __forceinline__ void done(const pg8::Unit&) const {}
};

struct EpiResid {
    static constexpr bool PERM = false, AFTER_DRAIN = false;
    static __device__ __forceinline__ bool keep_acc(const pg8::Unit&) { return false; }
    const float* xsrc; float* xl; float* part; const float* mod; int gi;
    __device__ __forceinline__ void operator()(const f32x4 (&acc)[2][2][4][2], const pg8::Unit& u, int wr, int wc, int fr, int fq) const {
        const int bidx = u.pm < 64 ? (u.pm >> 3) : 8;
        const float* gate = mod + (size_t)bidx * 6144 + gi * 1024;
        const int col0 = u.pn * 256 + wc * 32 + fq * 4;
        const int row0 = u.pm * 256 + wr * 64 + fr;
        const bool lat = u.pm < 64;
        float* base = lat ? xl + (size_t)row0 * DM + col0 : part + ((size_t)u.ks * MC + (size_t)(row0 - ML)) * DM + col0;
        const float* rsrc = xsrc + (size_t)row0 * DM + col0;
#pragma unroll
        for (int bj = 0; bj < 2; ++bj) {
            f32x4 gv[2], xv[16];
#pragma unroll
            for (int n = 0; n < 2; ++n) gv[n] = *(const f32x4*)(gate + col0 + bj * 128 + n * 16);
#pragma unroll
            for (int n = 0; n < 2; ++n)
#pragma unroll
                for (int k = 0; k < 8; ++k) xv[n * 8 + k] = lat ? *(const f32x4*)(rsrc + (size_t)((k >> 2) * 128 + (k & 3) * 16) * DM + bj * 128 + n * 16) : (f32x4){0.f, 0.f, 0.f, 0.f};
            __builtin_amdgcn_sched_barrier(0);
#pragma unroll
            for (int n = 0; n < 2; ++n)
#pragma unroll
                for (int ai = 0; ai < 2; ++ai)
#pragma unroll
                    for (int m = 0; m < 4; ++m) {
                        const size_t off = (size_t)(ai * 128 + m * 16) * DM + bj * 128 + n * 16;
                        *(f32x4*)(base + off) = gv[n] * acc[ai][bj][m][n] + xv[n * 8 + ai * 4 + m];
                    }
            __builtin_amdgcn_sched_barrier(0);
        }
    }
};
struct EpiMlp1 {
    static constexpr bool PERM = true, AFTER_DRAIN = false;
    static __device__ __forceinline__ bool keep_acc(const pg8::Unit&) { return false; }
    bf16_t* H;
    __device__ __forceinline__ void operator()(const f32x4 (&acc)[2][2][4][2], const pg8::Unit& u, int wr, int wc, int fr, int fq) const {
        const int col0 = u.pn * 256 + wc * 32 + fq * 8;
#pragma unroll
        for (int ai = 0; ai < 2; ++ai)
#pragma unroll
            for (int m = 0; m < 4; ++m) {
                const int row = u.pm * 256 + ai * 128 + wr * 64 + m * 16 + fr;
                bf16_t* rp = H + (size_t)row * DFF + col0;
#pragma unroll
                for (int bj = 0; bj < 2; ++bj) {
                    f32x4 v0 = acc[ai][bj][m][0], v1 = acc[ai][bj][m][1];
#pragma unroll
                    for (int e = 0; e < 4; ++e) { const float r0 = fmaxf(v0[e], 0.f), r1 = fmaxf(v1[e], 0.f); v0[e] = r0 * r0; v1[e] = r1 * r1; }
                    u32x4 w; w.x = cvtpk(v0[0], v0[1]); w.y = cvtpk(v0[2], v0[3]); w.z = cvtpk(v1[0], v1[1]); w.w = cvtpk(v1[2], v1[3]);
                    *(u32x4*)(rp + bj * 128) = w;
                }
            }
    }
};

namespace att {
constexpr int KPB = 272, VPB = 320;
constexpr int KBUF = 64 * KPB, VBUF = 64 * VPB;
constexpr int OFF_K = 0, OFF_V = 2 * KBUF, OFF_RPB = OFF_V + 2 * VBUF;
typedef short v4i16_t __attribute__((ext_vector_type(4)));

struct TileRegs { u32x4 r[4]; };
__device__ __forceinline__ void tile_load(TileRegs& R, const bf16_t* KVb, int trow0, int tid) {
    const bf16_t* src = KVb + (size_t)trow0 * KVROW + tid * 8;
#pragma unroll
    for (int i = 0; i < 4; ++i) R.r[i] = *(const u32x4*)(src + i * 4096);
}
__device__ __forceinline__ void tile_store(const TileRegs& R, LAS unsigned char* Kb, LAS unsigned char* Vb, int tid) {
    const int ch = tid & 31, row = tid >> 5;
    LAS unsigned char* d = ch < 16 ? Kb + row * KPB + ch * 16 : Vb + row * VPB + (ch - 16) * 16;
    const int step = ch < 16 ? 16 * KPB : 16 * VPB;
#pragma unroll
    for (int i = 0; i < 4; ++i) *(LAS u32x4*)(d + i * step) = R.r[i];
}
__device__ __forceinline__ bf16x8 pack8(const f32x16& s, int b) {
    u32x4 w; w.x = cvtpk(s[b], s[b + 1]); w.y = cvtpk(s[b + 2], s[b + 3]); w.z = cvtpk(s[b + 4], s[b + 5]); w.w = cvtpk(s[b + 6], s[b + 7]);
    return __builtin_bit_cast(bf16x8, w);
}
template <int NDV, int MODE>
__device__ __forceinline__ void attn_qks(LAS const unsigned char* Kt, const bf16x8 (&qf)[4], f32x16 (&o)[NDV], f32x16& lacc, float& m, bf16x8 (&pf)[4],
                                         int r32, int hi, LAS const float* brow, int qc, int cs) {
    bf16x8 kf[8];
#pragma unroll
    for (int ks = 0; ks < 4; ++ks) {
        kf[2 * ks] = *(LAS const bf16x8*)(Kt + r32 * KPB + ks * 32 + hi * 16);
        kf[2 * ks + 1] = *(LAS const bf16x8*)(Kt + (32 + r32) * KPB + ks * 32 + hi * 16);
    }
    float bq0[16], bq1[16];
    if (MODE == 1) {
#pragma unroll
        for (int r = 0; r < 16; ++r) {
            const int kc0 = (r & 3) + 8 * (r >> 2) + 4 * hi, kc1 = kc0 + 32;
            const bool v0 = (unsigned)(kc0 - cs) < 16u, v1 = (unsigned)(kc1 - cs) < 16u;
            bq0[r] = brow[v0 ? (kc0 - qc + 15) : 0]; bq1[r] = brow[v1 ? (kc1 - qc + 15) : 0];
        }
    }
    __builtin_amdgcn_sched_barrier(0);
    f32x16 s0, s1;
#pragma unroll
    for (int r = 0; r < 16; ++r) { s0[r] = 0.f; s1[r] = 0.f; }
#pragma unroll
    for (int ks = 0; ks < 4; ++ks) {
        s0 = __builtin_amdgcn_mfma_f32_32x32x16_bf16(kf[2 * ks], qf[ks], s0, 0, 0, 0);
        s1 = __builtin_amdgcn_mfma_f32_32x32x16_bf16(kf[2 * ks + 1], qf[ks], s1, 0, 0, 0);
    }
    __builtin_amdgcn_sched_barrier(0);
    constexpr float C = 0.125f * LOG2E;
    if (MODE == 1) {
#pragma unroll
        for (int r = 0; r < 16; ++r) {
            const int kc0 = (r & 3) + 8 * (r >> 2) + 4 * hi, kc1 = kc0 + 32;
            const bool v0 = (unsigned)(kc0 - cs) < 16u, v1 = (unsigned)(kc1 - cs) < 16u;
            s0[r] = v0 ? __builtin_fmaf(s0[r], C, bq0[r] * LOG2E) : -1e30f;
            s1[r] = v1 ? __builtin_fmaf(s1[r], C, bq1[r] * LOG2E) : -1e30f;
        }
    }
    float mx = __builtin_fmaxf(s0[0], s1[0]);
#pragma unroll
    for (int r = 1; r < 16; ++r) mx = __builtin_fmaxf(__builtin_fmaxf(mx, s0[r]), s1[r]);
    if (MODE == 0) mx *= C;
    mx = __builtin_fmaxf(mx, __shfl_xor(mx, 32));
    if (__any(mx > m + 8.0f)) {
        const float mn = __builtin_fmaxf(m, mx);
        const float alpha = __builtin_amdgcn_exp2f(m - mn);
        m = mn;
        lacc[0] *= alpha;
#pragma unroll
        for (int d0 = 0; d0 < NDV; ++d0)
#pragma unroll
            for (int r = 0; r < 16; ++r) o[d0][r] *= alpha;
    }
    const float nm = -m;
#pragma unroll
    for (int r = 0; r < 16; ++r) {
        if (MODE == 0) { s0[r] = __builtin_amdgcn_exp2f(__builtin_fmaf(s0[r], C, nm)); s1[r] = __builtin_amdgcn_exp2f(__builtin_fmaf(s1[r], C, nm)); }
        else { s0[r] = __builtin_amdgcn_exp2f(s0[r] + nm); s1[r] = __builtin_amdgcn_exp2f(s1[r] + nm); }
    }
    pf[0] = pack8(s0, 0); pf[1] = pack8(s0, 8); pf[2] = pack8(s1, 0); pf[3] = pack8(s1, 8);
}
template <int NDV>
__device__ __forceinline__ void attn_pv(LAS const unsigned char* Vt, const bf16x8 (&pf)[4], f32x16 (&o)[NDV], f32x16& lacc, int vlane) {
    const bf16x8 ones = {0x3F80, 0x3F80, 0x3F80, 0x3F80, 0x3F80, 0x3F80, 0x3F80, 0x3F80};
#pragma unroll
    for (int dp = 0; dp < NDV; dp += 2) {
        bf16x8 vq[8];
#pragma unroll
        for (int d0 = 0; d0 < 2; ++d0)
#pragma unroll
            for (int s = 0; s < 4; ++s) {
                LAS const unsigned char* vp = Vt + vlane + s * 16 * VPB + (dp + d0) * 64;
                const v4i16_t lo = __builtin_amdgcn_ds_read_tr16_b64_v4i16((LAS v4i16_t*)vp);
                const v4i16_t hh = __builtin_amdgcn_ds_read_tr16_b64_v4i16((LAS v4i16_t*)(vp + 8 * VPB));
                vq[d0 * 4 + s] = (bf16x8){lo[0], lo[1], lo[2], lo[3], hh[0], hh[1], hh[2], hh[3]};
            }
        __builtin_amdgcn_sched_barrier(0);
        if (dp == 0) {
#pragma unroll
            for (int s = 0; s < 4; ++s) lacc = __builtin_amdgcn_mfma_f32_32x32x16_bf16(ones, pf[s], lacc, 0, 0, 0);
        }
#pragma unroll
        for (int s = 0; s < 4; ++s) {
            o[dp] = __builtin_amdgcn_mfma_f32_32x32x16_bf16(vq[s], pf[s], o[dp], 0, 0, 0);
            o[dp + 1] = __builtin_amdgcn_mfma_f32_32x32x16_bf16(vq[4 + s], pf[s], o[dp + 1], 0, 0, 0);
        }
        __builtin_amdgcn_sched_barrier(0);
    }
}
#define ATT_BAR() asm volatile("s_waitcnt lgkmcnt(0)\n\ts_barrier" ::: "memory")

#define ATT_SB() __builtin_amdgcn_sched_barrier(0)
constexpr int OFF3_K = 0, OFF3_V = 3 * KBUF, OFF3_Q = 3 * KBUF + 3 * VBUF;
__device__ __forceinline__ bf16x8 vfrag(LAS const unsigned char* vp) {
    const v4i16_t lo = __builtin_amdgcn_ds_read_tr16_b64_v4i16((LAS v4i16_t*)vp);
    const v4i16_t hh = __builtin_amdgcn_ds_read_tr16_b64_v4i16((LAS v4i16_t*)(vp + 8 * VPB));
    return (bf16x8){lo[0], lo[1], lo[2], lo[3], hh[0], hh[1], hh[2], hh[3]};
}
__device__ __forceinline__ void st_qk(LAS const unsigned char* Kt, LAS const unsigned char* Qt, f32x16& s0, f32x16& s1, int r32, int hi) {
    bf16x8 ka[4], qa[2];
#pragma unroll
    for (int ks = 0; ks < 2; ++ks) {
        ka[2 * ks] = *(LAS const bf16x8*)(Kt + r32 * KPB + ks * 32 + hi * 16);
        ka[2 * ks + 1] = *(LAS const bf16x8*)(Kt + (32 + r32) * KPB + ks * 32 + hi * 16);
        qa[ks] = *(LAS const bf16x8*)(Qt + r32 * KPB + ks * 32 + hi * 16);
    }
    ATT_SB();
#pragma unroll
    for (int r = 0; r < 16; ++r) { s0[r] = 0.f; s1[r] = 0.f; }
#pragma unroll
    for (int ks = 0; ks < 2; ++ks) {
        s0 = __builtin_amdgcn_mfma_f32_32x32x16_bf16(ka[2 * ks], qa[ks], s0, 0, 0, 0);
        s1 = __builtin_amdgcn_mfma_f32_32x32x16_bf16(ka[2 * ks + 1], qa[ks], s1, 0, 0, 0);
    }
    ATT_SB();
    bf16x8 kb[4], qb[2];
#pragma unroll
    for (int ks = 0; ks < 2; ++ks) {
        kb[2 * ks] = *(LAS const bf16x8*)(Kt + r32 * KPB + (ks + 2) * 32 + hi * 16);
        kb[2 * ks + 1] = *(LAS const bf16x8*)(Kt + (32 + r32) * KPB + (ks + 2) * 32 + hi * 16);
        qb[ks] = *(LAS const bf16x8*)(Qt + r32 * KPB + (ks + 2) * 32 + hi * 16);
    }
    ATT_SB();
#pragma unroll
    for (int ks = 0; ks < 2; ++ks) {
        s0 = __builtin_amdgcn_mfma_f32_32x32x16_bf16(kb[2 * ks], qb[ks], s0, 0, 0, 0);
        s1 = __builtin_amdgcn_mfma_f32_32x32x16_bf16(kb[2 * ks + 1], qb[ks], s1, 0, 0, 0);
    }
    ATT_SB();
}
__device__ __forceinline__ void st_softmax(f32x16& s0, f32x16& s1, f32x16 (&o)[4], float& lsum, float& m, bf16x8 (&pf)[4]) {
    constexpr float C = 0.125f * LOG2E;
    float mx = __builtin_fmaxf(s0[0], s1[0]);
#pragma unroll
    for (int r = 1; r < 16; ++r) mx = __builtin_fmaxf(__builtin_fmaxf(mx, s0[r]), s1[r]);
    mx *= C;
    mx = __builtin_fmaxf(mx, __shfl_xor(mx, 32));
    if (__any(mx > m + 8.0f)) {
        const float mn = __builtin_fmaxf(m, mx);
        const float alpha = __builtin_amdgcn_exp2f(m - mn);
        m = mn;
        lsum *= alpha;
#pragma unroll
        for (int d0 = 0; d0 < 4; ++d0)
#pragma unroll
            for (int r = 0; r < 16; ++r) o[d0][r] *= alpha;
    }
    const float nm = -m;
    float rs = 0.f;
#pragma unroll
    for (int r = 0; r < 16; ++r) { s0[r] = __builtin_amdgcn_exp2f(__builtin_fmaf(s0[r], C, nm)); s1[r] = __builtin_amdgcn_exp2f(__builtin_fmaf(s1[r], C, nm)); rs += s0[r] + s1[r]; }
    lsum += rs;
    pf[0] = pack8(s0, 0); pf[1] = pack8(s0, 8); pf[2] = pack8(s1, 0); pf[3] = pack8(s1, 8);
#pragma unroll
    for (int q_ = 0; q_ < 32; ++q_) { __builtin_amdgcn_sched_group_barrier(0x400, 1, 0); __builtin_amdgcn_sched_group_barrier(0x002, 3, 0); }
}
__device__ __forceinline__ void st_pv(LAS const unsigned char* Vt, const bf16x8 (&va)[4], const bf16x8 (&pf)[4], f32x16 (&o)[4], int vlane) {
    ATT_SB();
#pragma unroll
    for (int s = 0; s < 4; ++s) o[0] = __builtin_amdgcn_mfma_f32_32x32x16_bf16(va[s], pf[s], o[0], 0, 0, 0);
    ATT_SB();
    bf16x8 vb[4];
#pragma unroll
    for (int s = 0; s < 4; ++s) vb[s] = vfrag(Vt + vlane + s * 16 * VPB + 1 * 64);
    ATT_SB();
#pragma unroll
    for (int s = 0; s < 4; ++s) o[1] = __builtin_amdgcn_mfma_f32_32x32x16_bf16(vb[s], pf[s], o[1], 0, 0, 0);
    ATT_SB();
    bf16x8 vc[4];
#pragma unroll
    for (int s = 0; s < 4; ++s) vc[s] = vfrag(Vt + vlane + s * 16 * VPB + 2 * 64);
    ATT_SB();
#pragma unroll
    for (int s = 0; s < 4; ++s) o[2] = __builtin_amdgcn_mfma_f32_32x32x16_bf16(vc[s], pf[s], o[2], 0, 0, 0);
    ATT_SB();
    bf16x8 vd[4];
#pragma unroll
    for (int s = 0; s < 4; ++s) vd[s] = vfrag(Vt + vlane + s * 16 * VPB + 3 * 64);
    ATT_SB();
#pragma unroll
    for (int s = 0; s < 4; ++s) o[3] = __builtin_amdgcn_mfma_f32_32x32x16_bf16(vd[s], pf[s], o[3], 0, 0, 0);
    ATT_SB();
}

__device__ __forceinline__ void diff_unit(const Params& p, int l, LAS unsigned char* lds, int b, int h, int qrow0, int NT) {
    const int tid = fresh_tid(), lane = tid & 63, w = __builtin_amdgcn_readfirstlane(tid >> 6), r32 = lane & 31, hi = lane >> 5;
    const int map = w >> 2, qs = w & 3;
    const bf16_t* Z1 = (const bf16_t*)(p.ws + WS_Z1);
    const int qrow = qrow0 + qs * 32 + r32;
    {
        u32x4 qv[4];
#pragma unroll
        for (int i = 0; i < 4; ++i) { const int c = tid + 512 * i, row = c >> 4, ch = c & 15; qv[i] = *(const u32x4*)(Z1 + (size_t)(qrow0 + row) * ZC + h * 128 + ch * 8); }
#pragma unroll
        for (int i = 0; i < 4; ++i) { const int c = tid + 512 * i, row = c >> 4, ch = c & 15; *(LAS u32x4*)(lds + OFF3_Q + row * KPB + ch * 16) = qv[i]; }
    }
    LAS const unsigned char* Qt = lds + OFF3_Q + (qs * 32) * KPB + map * 128;
    const bf16_t* KVb = (const bf16_t*)(p.ws + WS_KVD) + (size_t)(b * 4 + h) * KVT * KVROW;
    const int vlane = (4 * hi + ((lane & 15) >> 2)) * VPB + ((lane >> 4) & 1) * 32 + (lane & 3) * 8;
    f32x16 o[4];
#pragma unroll
    for (int d0 = 0; d0 < 4; ++d0)
#pragma unroll
        for (int r = 0; r < 16; ++r) o[d0][r] = 0.f;
    float m = -1e30f, lsum = 0.f;
    TileRegs R;
#define DIFF_TROW(j) ((j) * 64)
    tile_load(R, KVb, DIFF_TROW(0), tid);
    tile_store(R, lds + OFF3_K, lds + OFF3_V, tid);
    if (1 < NT) { tile_load(R, KVb, DIFF_TROW(1), tid); tile_store(R, lds + OFF3_K + KBUF, lds + OFF3_V + VBUF, tid); }
    if (2 < NT) tile_load(R, KVb, DIFF_TROW(2), tid);
    __syncthreads();
    f32x16 sa0, sa1, sb0, sb1;
    st_qk(lds + OFF3_K + map * 128, Qt, sa0, sa1, r32, hi);
    int bj = 0;
#define DIFF_STEP(jj, SC0, SC1, SN0, SN1) do { \
        const int b1 = (bj == 2) ? 0 : bj + 1, b2 = (b1 == 2) ? 0 : b1 + 1; \
        if ((jj) + 2 < NT) tile_store(R, lds + OFF3_K + b2 * KBUF, lds + OFF3_V + b2 * VBUF, tid); \
        if ((jj) + 3 < NT) tile_load(R, KVb, DIFF_TROW((jj) + 3), tid); \
        if ((jj) + 1 < NT) st_qk(lds + OFF3_K + b1 * KBUF + map * 128, Qt, SN0, SN1, r32, hi); \
        LAS const unsigned char* Vt_ = lds + OFF3_V + bj * VBUF; \
        bf16x8 pf_[4]; \
        st_softmax(SC0, SC1, o, lsum, m, pf_); \
        ATT_SB(); \
        bf16x8 va_[4]; \
        _Pragma("unroll") for (int s_ = 0; s_ < 4; ++s_) va_[s_] = vfrag(Vt_ + vlane + s_ * 16 * VPB); \
        st_pv(Vt_, va_, pf_, o, vlane); \
        ATT_BAR(); \
        bj = b1; \
    } while (0)
    for (int j = 0; j < NT; j += 2) {
        DIFF_STEP(j, sa0, sa1, sb0, sb1);
        if (j + 1 < NT) DIFF_STEP(j + 1, sb0, sb1, sa0, sa1);
    }
#undef DIFF_STEP
    __syncthreads();
#undef DIFF_TROW
    int l_ = l; asm volatile("" : "+s"(l_));
    const float lam_init = l_ == 0 ? 0.200000000f : l_ == 1 ? 0.355509068f : l_ == 2 ? 0.470713018f : 0.556058204f;
    float lam;
    { const float a_ = p.lq1[l * 64 + lane] * p.lk1[l * 64 + lane], b_ = p.lq2[l * 64 + lane] * p.lk2[l * 64 + lane];
      lam = __expf(wave_sum(a_)) - __expf(wave_sum(b_)) + lam_init; }
    const float inv = 1.0f / (lsum + __shfl_xor(lsum, 32));
    LAS float* X = (LAS float*)lds;
    if (map == 1) {
        const float f = -lam * inv;
#pragma unroll
        for (int d0 = 0; d0 < 4; ++d0)
#pragma unroll
            for (int r = 0; r < 16; ++r) X[((qs * 4 + d0) * 16 + r) * 64 + lane] = o[d0][r] * f;
    }
    __syncthreads();
    if (map == 0) {
        f32x4 gq_[16];
        { const float* gs0 = p.g_subln + l * 128;
#pragma unroll
          for (int k = 0; k < 16; ++k) gq_[k] = *(const f32x4*)(gs0 + 32 * (k >> 2) + 8 * (k & 3) + 4 * hi); }
        __builtin_amdgcn_sched_barrier(0);
        float ss = 0.f;
#pragma unroll
        for (int d0 = 0; d0 < 4; ++d0)
#pragma unroll
            for (int r = 0; r < 16; ++r) { const float v = o[d0][r] * inv + X[((qs * 4 + d0) * 16 + r) * 64 + lane]; o[d0][r] = v; ss += v * v; }
        ss += __shfl_xor(ss, 32);
        const float rstd = rsqrtf(ss * (1.0f / 128.0f) + 1e-6f) * (1.0f - lam_init);
        bf16_t* orow = (bf16_t*)(p.ws + WS_A3) + (size_t)qrow * 512 + h * 128;
        const float* gs = p.g_subln + l * 128;
#pragma unroll
        for (int d0 = 0; d0 < 4; ++d0)
#pragma unroll
            for (int a = 0; a < 4; ++a) {
                const int dv = 32 * d0 + 8 * a + 4 * hi;
                const f32x4 g = gq_[d0 * 4 + a];
                u32x2 wv; wv.x = cvtpk(o[d0][4 * a] * rstd * g[0], o[d0][4 * a + 1] * rstd * g[1]); wv.y = cvtpk(o[d0][4 * a + 2] * rstd * g[2], o[d0][4 * a + 3] * rstd * g[3]);
                *(u32x2*)(orow + dv) = wv;
            }
    }
    __syncthreads();
}

__device__ __forceinline__ void nat_unit(const Params& p, int l, LAS unsigned char* lds, int b, int hp, int mode, int idx) {
    const int tid = fresh_tid(), lane = tid & 63, w = __builtin_amdgcn_readfirstlane(tid >> 6), r32 = lane & 31, hi = lane >> 5;
    const int hsel = w & 1, head = 2 * hp + hsel;
    const bf16_t* Z1 = (const bf16_t*)(p.ws + WS_Z1);
    int qrow, qc = 0, cs = 0, grow = 0, s0r = 0, sr = 0, NT = 4;
    if (mode == 0) {
        const int rsel = (w >> 1) & 1, csel = w >> 2;
        grow = 2 * idx + rsel; qc = csel * 32 + r32; cs = min(max(qc - 8, 0), 48);
        qrow = b * 2048 + grow * 64 + qc;
        s0r = min(max(2 * idx - 4, 0), 24); const int s1r = min(max(2 * idx + 1 - 4, 0), 24);
        sr = rsel ? s1r : s0r; NT = 4 + (s1r + 8 - s0r);
    } else {
        const int qs = w >> 1;
        qrow = ML + b * 256 + idx * 128 + qs * 32 + r32;
    }
    bf16x8 qf[4];
#pragma unroll
    for (int ks = 0; ks < 4; ++ks) qf[ks] = *(const bf16x8*)(Z1 + (size_t)qrow * ZC + 1024 + head * 64 + ks * 16 + hi * 8);
    const bf16_t* KVb = (const bf16_t*)(p.ws + WS_KVN) + (size_t)(b * 4 + hp) * KVT * KVROW;
    const int vlane = (4 * hi + ((lane & 15) >> 2)) * VPB + ((lane >> 4) & 1) * 32 + (lane & 3) * 8;
    LAS float* rpbL = (LAS float*)(lds + OFF_RPB);
    { const float* src = p.nat_rpb + (size_t)(l * 8 + 2 * hp) * 465; for (int i = tid; i < 930; i += 512) rpbL[i] = src[i]; }
    f32x16 o[2];
#pragma unroll
    for (int d0 = 0; d0 < 2; ++d0)
#pragma unroll
        for (int r = 0; r < 16; ++r) o[d0][r] = 0.f;
    float m = -1e30f; f32x16 lacc;
#pragma unroll
    for (int r = 0; r < 16; ++r) lacc[r] = 0.f;
    TileRegs R;
#define NAT_TROW(j) ((j) < 4 ? (j) * 64 : 256 + (s0r + (j) - 4) * 64)
    TileRegs Rb;
    tile_load(R, KVb, NAT_TROW(0), tid);
    tile_store(R, lds + OFF_K, lds + OFF_V, tid);
    if (1 < NT) tile_load(R, KVb, NAT_TROW(1), tid);
    if (2 < NT) tile_load(Rb, KVb, NAT_TROW(2), tid);
    __syncthreads();
    bf16x8 pf[4];
#define NAT_STEP(jj, KB, VB) do { \
        LAS const unsigned char* Kt = lds + OFF_K + (KB) + hsel * 128; LAS const unsigned char* Vt = lds + OFF_V + (VB) + hsel * 128; \
        const int kr = s0r + (jj) - 4; \
        if ((jj) < 4) { attn_qks<2, 0>(Kt, qf, o, lacc, m, pf, r32, hi, nullptr, 0, 0); attn_pv<2>(Vt, pf, o, lacc, vlane); } \
        else if (kr >= sr && kr < sr + 8) { attn_qks<2, 1>(Kt, qf, o, lacc, m, pf, r32, hi, rpbL + (hsel * 15 + (kr - grow + 7)) * 31, qc, cs); attn_pv<2>(Vt, pf, o, lacc, vlane); } \
    } while (0)
    for (int j = 0; j < NT; j += 2) {
        NAT_STEP(j, 0, 0);
        if (j + 1 < NT) tile_store(R, lds + OFF_K + KBUF, lds + OFF_V + VBUF, tid);
        if (j + 3 < NT) tile_load(R, KVb, NAT_TROW(j + 3), tid);
        ATT_BAR();
        if (j + 1 < NT) {
            NAT_STEP(j + 1, KBUF, VBUF);
            if (j + 2 < NT) tile_store(Rb, lds + OFF_K, lds + OFF_V, tid);
            if (j + 4 < NT) tile_load(Rb, KVb, NAT_TROW(j + 4), tid);
            ATT_BAR();
        }
    }
#undef NAT_STEP
    __syncthreads();
#undef NAT_TROW
    const float inv = 1.0f / lacc[0];
    bf16_t* orow = (bf16_t*)(p.ws + WS_A3) + (size_t)2 * MT * 512 + (size_t)qrow * 512 + head * 64;
#pragma unroll
    for (int d0 = 0; d0 < 2; ++d0)
#pragma unroll
        for (int a = 0; a < 4; ++a) {
            const int dv = 32 * d0 + 8 * a + 4 * hi;
            u32x2 wv; wv.x = cvtpk(o[d0][4 * a] * inv, o[d0][4 * a + 1] * inv); wv.y = cvtpk(o[d0][4 * a + 2] * inv, o[d0][4 * a + 3] * inv);
            *(u32x2*)(orow + dv) = wv;
        }
}
}

__device__ __forceinline__ void pool_unit(const Params& p, int unit) {
    const int tid = fresh_tid(), lane = tid & 63, w = tid >> 6;
    const bf16_t* Z1 = (const bf16_t*)(p.ws + WS_Z1);
    bf16_t* P = (bf16_t*)(p.ws + WS_A3) + (size_t)MT * 512;
    const int half = 1 << (lane >> 4);
#pragma unroll 2
    for (int i = 0; i < 8; ++i) {
        const int row = unit * 64 + w * 8 + i;
        int sb, t, L;
        if (row < ML) { sb = row & ~2047; t = row & 2047; L = 2048; } else { sb = ML + ((row - ML) & ~255); t = (row - ML) & 255; L = 256; }
        const int lo = max(t - half, 0), hi = min(t + half, L);
        float acc[8];
#pragma unroll
        for (int e = 0; e < 8; ++e) acc[e] = 0.f;
        const bf16_t* base = Z1 + (size_t)sb * ZC + 512 + lane * 8;
        u32x4 wv[16];
#pragma unroll
        for (int k = 0; k < 16; ++k) { const int s_ = lo + k; wv[k] = *(const u32x4*)(base + (size_t)(s_ < hi ? s_ : lo) * ZC); }
        const u32x4 sv = *(const u32x4*)(base + (size_t)t * ZC);
        __builtin_amdgcn_sched_barrier(0);
#pragma unroll
        for (int k = 0; k < 16; ++k) {
            const float f_ = (lo + k < hi) ? 1.0f : 0.0f; const u32x4 v = wv[k];
            acc[0] += f_ * __uint_as_float(v.x << 16); acc[1] += f_ * __uint_as_float(v.x & 0xffff0000u);
            acc[2] += f_ * __uint_as_float(v.y << 16); acc[3] += f_ * __uint_as_float(v.y & 0xffff0000u);
            acc[4] += f_ * __uint_as_float(v.z << 16); acc[5] += f_ * __uint_as_float(v.z & 0xffff0000u);
            acc[6] += f_ * __uint_as_float(v.w << 16); acc[7] += f_ * __uint_as_float(v.w & 0xffff0000u);
        }
        const float ic = 1.0f / (float)(hi - lo);
        float uu[8] = {__uint_as_float(sv.x << 16), __uint_as_float(sv.x & 0xffff0000u), __uint_as_float(sv.y << 16), __uint_as_float(sv.y & 0xffff0000u),
                       __uint_as_float(sv.z << 16), __uint_as_float(sv.z & 0xffff0000u), __uint_as_float(sv.w << 16), __uint_as_float(sv.w & 0xffff0000u)};
        u32x4 ov; ov.x = cvtpk(acc[0] * ic - uu[0], acc[1] * ic - uu[1]); ov.y = cvtpk(acc[2] * ic - uu[2], acc[3] * ic - uu[3]);
        ov.z = cvtpk(acc[4] * ic - uu[4], acc[5] * ic - uu[5]); ov.w = cvtpk(acc[6] * ic - uu[6], acc[7] * ic - uu[7]);
        *(u32x4*)(P + (size_t)row * 512 + lane * 8) = ov;
    }
}

__device__ __forceinline__ void norm_rows(const Params& p, int l, int nrows, const float* gvec, int si, bool use_part, const float* srcL, const float* srcC) {
    const int tid = fresh_tid(), lane = tid & 63, w = tid >> 6;
    bf16_t* HN = (bf16_t*)(p.ws + WS_HN);
    const float* MOD = (const float*)(p.ws + WS_MOD) + (size_t)l * 9 * 6144;
    for (int row = blockIdx.x * 8 + w; row < nrows; row += gridDim.x * 8) {
        const float* xr = row < ML ? srcL + (size_t)row * DM : srcC + (size_t)(row - ML) * DM;
        const int b = row < ML ? (row >> 11) : 8;
        const float* sh = MOD + (size_t)b * 6144 + si * 1024; const float* sc = sh + 1024;
        f32x4 v[4], gq[4], s1q[4], s0q[4]; float ss = 0.f;
#pragma unroll
        for (int j = 0; j < 4; ++j) v[j] = ((const f32x4*)xr)[64 * j + lane];
#pragma unroll
        for (int j = 0; j < 4; ++j) { const int col = (64 * j + lane) * 4; gq[j] = *(const f32x4*)(gvec + col); s1q[j] = *(const f32x4*)(sc + col); s0q[j] = *(const f32x4*)(sh + col); }
        __builtin_amdgcn_sched_barrier(0);
        if (use_part && row >= ML) {
            const f32x4* pp = (const f32x4*)((const float*)(p.ws + WS_PART) + (size_t)(row - ML) * DM);
#pragma unroll
            for (int kh = 0; kh < 2; ++kh) {
                f32x4 pq[16];
#pragma unroll
                for (int k = 0; k < 4; ++k)
#pragma unroll
                    for (int j = 0; j < 4; ++j) pq[k * 4 + j] = pp[(size_t)(kh * 4 + k) * (MC * DM / 4) + 64 * j + lane];
                __builtin_amdgcn_sched_barrier(0);
#pragma unroll
                for (int k = 0; k < 4; ++k)
#pragma unroll
                    for (int j = 0; j < 4; ++j) v[j] += pq[k * 4 + j];
            }
#pragma unroll
            for (int j = 0; j < 4; ++j) ((f32x4*)xrow_ptr(p, row))[64 * j + lane] = v[j];
        }
#pragma unroll
        for (int j = 0; j < 4; ++j) ss += (v[j][0] * v[j][0] + v[j][1] * v[j][1]) + (v[j][2] * v[j][2] + v[j][3] * v[j][3]);
        const float rstd = rsqrtf(wave_sum(ss) * (1.0f / 1024.0f) + 1e-6f);
#pragma unroll
        for (int j = 0; j < 4; ++j) {
            const int col = (64 * j + lane) * 4;
            const f32x4 hv = v[j] * rstd * gq[j] * (s1q[j] + 1.0f) + s0q[j];
            u32x2 wv; wv.x = cvtpk(hv[0], hv[1]); wv.y = cvtpk(hv[2], hv[3]);
            *(u32x2*)(HN + (size_t)row * DM + col) = wv;
        }
    }
}
__device__ __forceinline__ void final_norm(const Params& p) {
    const int tid = fresh_tid(), lane = tid & 63, w = tid >> 6;
    for (int row = blockIdx.x * 8 + w; row < ML; row += gridDim.x * 8) {
        float* xr = p.out + (size_t)row * DM;
        f32x4 v[4], gq[4]; float ss = 0.f;
#pragma unroll
        for (int j = 0; j < 4; ++j) { v[j] = ((const f32x4*)xr)[64 * j + lane]; gq[j] = ((const f32x4*)p.g_final)[64 * j + lane]; }
        __builtin_amdgcn_sched_barrier(0);
#pragma unroll
        for (int j = 0; j < 4; ++j) ss += (v[j][0] * v[j][0] + v[j][1] * v[j][1]) + (v[j][2] * v[j][2] + v[j][3] * v[j][3]);
        const float rstd = rsqrtf(wave_sum(ss) * (1.0f / 1024.0f) + 1e-6f);
#pragma unroll
        for (int j = 0; j < 4; ++j) ((f32x4*)xr)[64 * j + lane] = v[j] * rstd * gq[j];
    }
}
__device__ __forceinline__ void cvt_item(const float* W, int K, int N, bf16_t* WT, int item, LAS float* scr, int lane, int nperm = 0) {
    const int nblk = N >> 5, kb = item / nblk, nb = item - kb * nblk, k0 = kb * 64, n0 = nb * 32;
    const int pl = lane & 31, srcn = (n0 < nperm) ? (16 * ((pl >> 2) & 1) + 4 * (pl >> 3) + (pl & 3)) : pl;
    float wq_[32];
#pragma unroll
    for (int i = 0; i < 32; ++i) wq_[i] = W[(size_t)(k0 + 2 * i + (lane >> 5)) * N + n0 + srcn];
    __builtin_amdgcn_sched_barrier(0);
#pragma unroll
    for (int i = 0; i < 32; ++i) scr[(2 * i + (lane >> 5)) * 33 + (lane & 31)] = wq_[i];
    asm volatile("s_waitcnt lgkmcnt(0)" ::: "memory");
    const int c = lane & 7;
#pragma unroll
    for (int j = 0; j < 4; ++j) { const int n = (lane >> 3) + 8 * j; LAS const float* sp = scr + (8 * c) * 33 + n;
        u32x4 o; o.x = cvtpk(sp[0], sp[33]); o.y = cvtpk(sp[2 * 33], sp[3 * 33]); o.z = cvtpk(sp[4 * 33], sp[5 * 33]); o.w = cvtpk(sp[6 * 33], sp[7 * 33]);
        *(u32x4*)(WT + (size_t)(n0 + n) * K + k0 + 8 * c) = o; }
    asm volatile("s_waitcnt lgkmcnt(0)" ::: "memory");
}
__device__ __forceinline__ void fold_unit(const Params& p, int l, int unit, LAS float* scr, size_t wo) {
    const int tid = fresh_tid(), g = unit >> 5, nt = (unit >> 1) & 15, ct = unit & 1;
    LAS float* As = scr; LAS float* Bs = scr + 64 * 129;
    const float* pw = p.pool_w + ((size_t)(l * 4 + g) * 128 + ct * 64) * 128;
    const float* ps = p.pool_scale + l * 512 + g * 128;
    const float* wb = p.w_branch + ((size_t)(l * 3 + 1) * 512 + g * 128) * 1024 + nt * 64;
    for (int i = tid; i < 64 * 128; i += 512) { const int c = i >> 7, e = i & 127; As[c * 129 + e] = pw[(size_t)c * 128 + e]; }
    for (int i = tid; i < 128 * 64; i += 512) { const int e = i >> 6, n = i & 63; Bs[e * 65 + n] = ps[e] * wb[(size_t)e * 1024 + n]; }
    __syncthreads();
    const int n = tid >> 3, cc = tid & 7;
    float acc[8];
#pragma unroll
    for (int j = 0; j < 8; ++j) acc[j] = 0.f;
    for (int e = 0; e < 128; ++e) {
        const float bv = Bs[e * 65 + n];
#pragma unroll
        for (int j = 0; j < 8; ++j) acc[j] += As[(cc * 8 + j) * 129 + e] * bv;
    }
    bf16_t* dst = (bf16_t*)(p.ws + wo + WS_WBR) + (size_t)(1024 + nt * 64 + n) * 512 + g * 128 + ct * 64 + cc * 8;
    u32x4 o; o.x = cvtpk(acc[0], acc[1]); o.y = cvtpk(acc[2], acc[3]); o.z = cvtpk(acc[4], acc[5]); o.w = cvtpk(acc[6], acc[7]);
    *(u32x4*)dst = o;
    __syncthreads();
}

__device__ __forceinline__ void adaln_units(const Params& p, LAS unsigned char* lds, int l0, int l1, int vb, int nb);
__device__ __forceinline__ void phase0(const Params& p, LAS unsigned char* lds) {
    const int tid = fresh_tid(), G = gridDim.x, bx = blockIdx.x;
    if (bx == 0 && tid < 16) {
        double inv = 1.0; for (int i = 0; i < tid; ++i) inv *= 0.5623413251903491;
        const double x2 = inv * inv; double term = inv, s = inv, c = 1.0, tc = 1.0;
        for (int k = 1; k <= 12; ++k) { term *= -x2 / (double)((2 * k) * (2 * k + 1)); s += term; tc *= -x2 / (double)((2 * k - 1) * (2 * k)); c += tc; }
        double cc = 1.0, sn = 0.0; float* T = (float*)(p.ws + WS_ROPE);
        for (int pos = 0; pos < 64; ++pos) { T[(pos * 16 + tid) * 2] = (float)cc; T[(pos * 16 + tid) * 2 + 1] = (float)sn; const double nc = cc * c - sn * s; sn = sn * c + cc * s; cc = nc; }
    }
    adaln_units(p, lds, 0, 1, bx, G);
}
__device__ __forceinline__ void adaln_units(const Params& p, LAS unsigned char* lds, int l0, int l1, int vb, int nb) {
    const int tid = fresh_tid();
    LAS float* sc = (LAS float*)lds; LAS float* red = sc + 9 * 1024;
    for (int i = tid; i < 9 * 1024; i += 512) { const int b = i >> 10, k = i & 1023; const float v = b < 8 ? p.c[b * 1024 + k] : p.c_ctx[k]; sc[i] = v / (1.0f + __expf(-v)); }
    __syncthreads();
    const int lane = tid & 63, w = tid >> 6;
    float* MOD = (float*)(p.ws + WS_MOD);
    for (int u = l0 * 96 + vb; u < l1 * 96; u += nb) {
        const int l = u / 96, n0 = (u - l * 96) * 64;
        float acc[9];
#pragma unroll
        for (int b = 0; b < 9; ++b) acc[b] = 0.f;
        const float* W = p.w_ada + (size_t)l * 1024 * 6144 + (size_t)(w * 128) * 6144 + n0 + lane;
#pragma unroll 1
        for (int k4 = 0; k4 < 128; k4 += 16) {
            float wq_[16];
#pragma unroll
            for (int i = 0; i < 16; ++i) wq_[i] = W[(size_t)(k4 + i) * 6144];
            __builtin_amdgcn_sched_barrier(0);
#pragma unroll
            for (int i = 0; i < 16; ++i) {
#pragma unroll
                for (int b = 0; b < 9; ++b) acc[b] += sc[b * 1024 + w * 128 + k4 + i] * wq_[i];
            }
        }
#pragma unroll
        for (int b = 0; b < 9; ++b) red[(w * 9 + b) * 64 + lane] = acc[b];
        __syncthreads();
        for (int i = tid; i < 576; i += 512) {
            const int b = i >> 6, ln = i & 63; float s = 0.f;
#pragma unroll
            for (int ww = 0; ww < 8; ++ww) s += red[(ww * 9 + b) * 64 + ln];
            MOD[(size_t)(l * 9 + b) * 6144 + n0 + ln] = s + p.b_ada[l * 6144 + n0 + ln];
        }
        __syncthreads();
    }
}

__device__ __forceinline__ void convert_weights(const Params& p, int l, LAS unsigned char* lds, int vb, int nb) {
    LAS float* scr = (LAS float*)lds;
    const size_t wo = (l & 1) ? WS_WSET1 : 0;
    {
        const int tid = fresh_tid(), lane = tid & 63, w = tid >> 6;
        LAS float* wscr = scr + w * (64 * 33);
        constexpr int T_IN = 16 * 208, T_BR = 8 * 32, T_OUT = 16 * 32, T_1 = 16 * 128, T_2 = 64 * 32, T_ALL = T_IN + 2 * T_BR + T_OUT + T_1 + T_2;
        for (int t = vb * 8 + w; t < T_ALL; t += nb * 8) {
            int r = t;
            if (r < T_IN) { cvt_item(p.w_in + (size_t)l * 1024 * INC, 1024, INC, (bf16_t*)(p.ws + wo + WS_WIN), r, wscr, lane, 1024); continue; } r -= T_IN;
            if (r < T_BR) { cvt_item(p.w_branch + (size_t)(l * 3 + 0) * 512 * 1024, 512, 1024, (bf16_t*)(p.ws + wo + WS_WBR), r, wscr, lane); continue; } r -= T_BR;
            if (r < T_BR) { cvt_item(p.w_branch + (size_t)(l * 3 + 2) * 512 * 1024, 512, 1024, (bf16_t*)(p.ws + wo + WS_WBR) + (size_t)2 * 1024 * 512, r, wscr, lane); continue; } r -= T_BR;
            if (r < T_OUT) { cvt_item(p.w_out + (size_t)l * 1024 * 1024, 1024, 1024, (bf16_t*)(p.ws + wo + WS_WOUT), r, wscr, lane); continue; } r -= T_OUT;
            if (r < T_1) { cvt_item(p.w_mlp1 + (size_t)l * 1024 * DFF, 1024, DFF, (bf16_t*)(p.ws + wo + WS_W1), r, wscr, lane); continue; } r -= T_1;
            cvt_item(p.w_mlp2 + (size_t)l * DFF * 1024, DFF, 1024, (bf16_t*)(p.ws + wo + WS_W2), r, wscr, lane);
        }
        __syncthreads();
    }
    for (int u = vb; u < 128; u += nb) fold_unit(p, l, u, scr, wo);
}
__device__ __forceinline__ void phaseA(const Params& p, int l, LAS unsigned char* lds) {
    if (l == 0) convert_weights(p, 0, lds, (int)blockIdx.x, (int)gridDim.x);
    norm_rows(p, l, MT, p.g_mix + l * 1024, 0, l > 0, l == 0 ? p.x : p.out, l == 0 ? p.ctx : (const float*)(p.ws + WS_XC));
}

__device__ __forceinline__ void phaseC(const Params& p, int l, LAS unsigned char* lds, int vb) {
    const int G = gridDim.x, lane = fresh_tid() & 63;
    const bool last = (l == DEPTH - 1);
    const int n_ctx = last ? 0 : 64;
    const int U1 = 512, U2 = 1024, U3 = U2 + n_ctx, U4 = U3 + n_ctx, U5 = U4 + (last ? ML : MT) / 64;
    for (int u = vb; u < U5; u += G) {
        if (u < U2) {
            const int uu = u & 511;
            const int vu = (G == 256) ? ((uu & 7) * 64 + (uu >> 8) * 32 + ((uu & 255) >> 3)) : uu;
            const int bh = vu >> 4, sub = vu & 15, b = bh >> 2, hq = bh & 3;
            if (u < U1) att::diff_unit(p, l, lds, b, hq, b * 2048 + sub * 128, 36);
            else att::nat_unit(p, l, lds, b, hq, 0, sub);
        } else if (u < U3) {
            const int v = u - U2, b = v >> 3, hq = (v >> 1) & 3, qb = v & 1;
            att::diff_unit(p, l, lds, b, hq, ML + b * 256 + qb * 128, 4);
        } else if (u < U4) {
            const int v = u - U3, b = v >> 3, hq = (v >> 1) & 3, qb = v & 1;
            att::nat_unit(p, l, lds, b, hq, 1, qb);
        } else {
            pool_unit(p, u - U4);
        }
    }
}

__global__ void __launch_bounds__(512, 2) fwd_megakernel(Params p) {
    extern __shared__ __attribute__((aligned(16))) unsigned char smem[];
    LAS unsigned char* lds = (LAS unsigned char*)smem;
    cg::grid_group grid = cg::this_grid();
    const int G = gridDim.x;
    volatile LAS unsigned* bst = (volatile LAS unsigned*)(lds + LDS_BYTES - 256);
    if (fresh_tid() < 2) bst[fresh_tid()] = 0u;
    __syncthreads();
    XcdBarrier bar = xcd_barrier_post((unsigned*)(p.ws + WS_CTL), bst);
    unsigned* cen = (unsigned*)(p.ws + WS_CTL) + 12288;
    if (fresh_tid() == 0) bst[2] = __hip_atomic_fetch_add(cen + bar.x * 16, 1u, __ATOMIC_RELAXED, __HIP_MEMORY_SCOPE_AGENT);
#ifndef ENABLE_MASK
#define ENABLE_MASK 0x3ff
#endif
#define PH_BEGIN(k) if (((ENABLE_MASK) >> (k)) & 1) {
#define PH_END   xcd_barrier(bar); }
#define PH_END0  if (p.ws == nullptr) grid.sync();        \
                 xcd_barrier(bar); }
#define PH_ENDL  }

    PH_BEGIN(0) phase0(p, lds); PH_END0
    if (fresh_tid() == 0) {
        bool even = (G % 8) == 0 && bar.x < 8u;
        for (int j = 0; j < 16; ++j) { const unsigned c_ = __hip_atomic_load(cen + j * 16, __ATOMIC_RELAXED, __HIP_MEMORY_SCOPE_AGENT); even = even && (c_ == (j < 8 ? (unsigned)(G / 8) : 0u)); }
        bst[3] = even ? bst[2] * 8u + bar.x : (unsigned)blockIdx.x;
    }
    __syncthreads();
    const int bx = __builtin_amdgcn_readfirstlane((int)bst[3]);

#pragma unroll 1
    for (int l = 0; l < DEPTH; ++l) {
        const bool last = (l == DEPTH - 1);
        const int Mx = last ? ML : MT;
        const float* MODl = (const float*)(p.ws + WS_MOD) + (size_t)l * 9 * 6144;
        const unsigned char* wsl = p.ws + ((l & 1) ? WS_WSET1 : 0);
        PH_BEGIN(1) phaseA(p, l, lds); PH_END
        PH_BEGIN(2) {
            pg8::Gemm g{(const bf16_t*)(p.ws + WS_HN), (const bf16_t*)(wsl + WS_WIN), MT, INC, DM}; InProjOrder S; S.init(G, bx, last ? 0 : 1);
            EpiInProj E{(bf16_t*)(p.ws + WS_Z1), (bf16_t*)(p.ws + WS_G), (const float*)(p.ws + WS_ROPE), (bf16_t*)(p.ws + WS_KVD), (bf16_t*)(p.ws + WS_KVN)};
            pg8::gemm_phase<EpiInProj, InProjOrder, true, true>(lds, g, S, E);
        } PH_END
        PH_BEGIN(3) phaseC(p, l, lds, bx); PH_END
        PH_BEGIN(4) {
            pg8::Gemm g{(const bf16_t*)(p.ws + WS_A3), (const bf16_t*)(wsl + WS_WBR), 3 * MT, 3 * 1024, 512}; BranchOrder S{last ? 0 : 32, G, bx};
            EpiBranch E{(const bf16_t*)(p.ws + WS_G), (bf16_t*)(p.ws + WS_MB)};
            pg8::gemm_phase<EpiBranch, BranchOrder, true, true>(lds, g, S, E);
            if (!last && G == 256) { if ((bx >> 3) >= 4) { adaln_units(p, lds, l + 1, l + 2, bx - 32, G - 32); __syncthreads(); convert_weights(p, l + 1, lds, bx - 32, G - 32); } }
            else if (!last) { adaln_units(p, lds, l + 1, l + 2, bx, G); __syncthreads(); convert_weights(p, l + 1, lds, bx, G); }
        } PH_END
        PH_BEGIN(5) {
            pg8::Gemm g{(const bf16_t*)(p.ws + WS_MB), (const bf16_t*)(wsl + WS_WOUT), Mx, DM, DM}; SplitOrder S; S.init(G, bx, DM, last ? 0 : 1);
            EpiResid E{l == 0 ? p.x : p.out, p.out, (float*)(p.ws + WS_PART), MODl, 2};
            pg8::gemm_phase<EpiResid, SplitOrder, true, true>(lds, g, S, E);
        } PH_END
        PH_BEGIN(6) norm_rows(p, l, Mx, p.g_mlp + l * 1024, 3, !last, p.out, l == 0 ? p.ctx : (const float*)(p.ws + WS_XC)); PH_END
        PH_BEGIN(7) {
            pg8::Gemm g{(const bf16_t*)(p.ws + WS_HN), (const bf16_t*)(wsl + WS_W1), Mx, DFF, DM}; pg8::StaticOrder S; S.init(Mx, DFF, G, bx, DM);
            EpiMlp1 E{(bf16_t*)(p.ws + WS_H)};
            pg8::gemm_phase<EpiMlp1, pg8::StaticOrder, true, true>(lds, g, S, E);
        } PH_END
        PH_BEGIN(8) {
            pg8::Gemm g{(const bf16_t*)(p.ws + WS_H), (const bf16_t*)(wsl + WS_W2), Mx, DM, DFF}; SplitOrder S; S.init(G, bx, DFF, last ? 0 : 1);
            EpiResid E{p.out, p.out, (float*)(p.ws + WS_PART), MODl, 5};
            pg8::gemm_phase<EpiResid, SplitOrder, true, true>(lds, g, S, E);
        } PH_END
    }
    PH_BEGIN(9) final_norm(p); PH_ENDL
#undef PH_BEGIN
#undef PH_END
#undef PH_END0
#undef PH_ENDL
}

#ifndef MK_MULTI
#define MK_MULTI 0
#endif
extern "C" void kernel_launch(void* const* d_in, const int* in_sizes, int n_in, void* d_out, int out_size, void* d_ws, size_t ws_size, hipStream_t stream) {
    static int grid_blocks = 0;
    if (grid_blocks == 0) {
        if (n_in != 22 || ws_size < WS_END) { fprintf(stderr, "kernel_launch: unexpected n_in %d / ws_size %zu (need %zu)\n", n_in, ws_size, (size_t)WS_END); grid_blocks = -1; return; }
        int dev = 0, cus = 0, per_cu = 0;
        hipGetDevice(&dev);
        hipDeviceGetAttribute(&cus, hipDeviceAttributeMultiprocessorCount, dev);
        if (hipFuncSetAttribute((const void*)fwd_megakernel, hipFuncAttributeMaxDynamicSharedMemorySize, LDS_BYTES) != hipSuccess) fprintf(stderr, "kernel_launch: hipFuncSetAttribute failed\n");
        hipOccupancyMaxActiveBlocksPerMultiprocessor(&per_cu, (const void*)fwd_megakernel, 512, LDS_BYTES);
        (void)hipGetLastError();
        if (per_cu < 1) { fprintf(stderr, "kernel_launch: occupancy query returned %d\n", per_cu); per_cu = 1; }
        grid_blocks = cus * per_cu;
    }
    if (grid_blocks < 0) return;
    if (hipMemsetAsync((char*)d_ws + WS_CTL, 0, 65536, stream) != hipSuccess) fprintf(stderr, "kernel_launch: memset failed\n");
    Params p{};
    const float** f = (const float**)&p;
    for (int i = 0; i < 22; ++i) f[i] = (const float*)d_in[i];
    p.out = (float*)d_out; p.ws = (unsigned char*)d_ws;
    void* args[] = {&p};
    hipError_t e = hipLaunchCooperativeKernel((const void*)fwd_megakernel, dim3(grid_blocks), dim3(512), args, LDS_BYTES, stream);
    if (e != hipSuccess) fprintf(stderr, "cooperative launch failed: %s (grid %d)\n", hipGetErrorString(e), grid_blocks);
}
```

```cpp
#include <hip/hip_runtime.h>
#include <hip/hip_cooperative_groups.h>
#include <cstdio>
#include <cstdint>
namespace cg = cooperative_groups;
__device__ __forceinline__ int fresh_tid() { int t = (int)threadIdx.x; asm volatile("" : "+v"(t)); return t; }
namespace pg8 {
#define PG8_LAS __attribute__((address_space(3)))
typedef unsigned short bf16_t;
typedef short bf16x8 __attribute__((ext_vector_type(8)));
typedef float f32x4 __attribute__((ext_vector_type(4)));
typedef unsigned u32x4 __attribute__((ext_vector_type(4)));
constexpr int BM = 256, BK = 64, HALF = 128, HTB = HALF * BK * 2  , STAGE_BYTES = 8 * HTB, NXCD = 8, WGM = 8;

__host__ __device__ __forceinline__ int lds_byte(int r, int c) { const int st = (r >> 4) * 2 + (c >> 5), rr = r & 15, cc = c & 31, ob = rr * 64 + cc * 2; return st * 1024 + (ob ^ (((ob >> 9) & 1) << 5)); }
__host__ __device__ __forceinline__ void stage_rc(int b, int& R, int& C) { const int st = b / 1024, sb = b % 1024, swz = sb ^ (((sb >> 9) & 1) << 5); R = (st >> 1) * 16 + swz / 64; C = (st & 1) * 32 + (swz % 64) / 2; }
__host__ __device__ __forceinline__ int perm32(int rho) { const int n = rho >> 4, i = rho & 15; return 8 * (i >> 2) + 4 * n + (i & 3); }

struct Unit { int pm, pn, koff, nt, ks; };
struct Gemm { const bf16_t* A; const bf16_t* Bt; int M, N, K; };

struct StaticOrder {
    int nM, nN, nwg, G, c, ntf;
    __host__ __device__ __forceinline__ void init(int M, int N, int G_, int c_, int K_) { nM = M / BM; nN = N / BM; nwg = nM * nN; G = G_; c = c_; ntf = K_ / BK; }
    __host__ __device__ __forceinline__ bool next(int i, Unit& u) const {
        const long L = (long)i * G + c; if (L >= nwg) return false;
        int wgid = (int)L; { const int q = nwg / NXCD, r = nwg % NXCD, xcd = wgid % NXCD, off = wgid / NXCD; wgid = (xcd < r ? xcd * (q + 1) : r * (q + 1) + (xcd - r) * q) + off; }
        const int nig = WGM * nN, gid = wgid / nig, fm = gid * WGM, gsz = (nM - fm) < WGM ? (nM - fm) : WGM;
        u.pm = fm + ((wgid % nig) % gsz); u.pn = (wgid % nig) / gsz; u.koff = 0; u.nt = ntf; u.ks = 0; return true;
    }
    __device__ __forceinline__ void a_ready(const Unit&) const {}
    __device__ __forceinline__ void done(const Unit&) const {}
};

template <class Epi, class Sched, bool ALIGN_EPI = false, bool SP2 = false>
__device__ __forceinline__ void gemm_phase(PG8_LAS unsigned char* lds, const Gemm g, const Sched& S, const Epi& E) {
    const int tid = fresh_tid(), wid = __builtin_amdgcn_readfirstlane(tid >> 6), lane = tid & 63, wr = wid >> 2, wc = wid & 3, fr = lane & 15, fq = lane >> 4;
    const int K = g.K;
    unsigned voffA[2], voffB[2];
#pragma unroll
    for (int i = 0; i < 2; ++i) { int R, C; stage_rc(tid * 16 + i * 8192, R, C); const int Rb = Epi::PERM ? ((R & ~31) + perm32(R & 31)) : R;
        voffA[i] = (unsigned)(R * K + C) * 2u; voffB[i] = (unsigned)(Rb * K + C) * 2u; }
    const size_t kstep = (size_t)(BK * 2);
    const size_t hstep = (size_t)HALF * K * 2;
    const size_t tstep = 2 * hstep;
    const unsigned ldsw = (unsigned)wid * 1024u;
    const int aoff = lds_byte(wr * 64 + fr, fq * 8), boff = lds_byte(wc * 32 + fr, fq * 8);
#define PG8_SA(b, h) (((b) * 2 + (h)) * HTB)
#define PG8_SB(b, h) ((4 + (b) * 2 + (h)) * HTB)
#define PG8_STAGE(bufoff, gbase, voff) do { _Pragma("unroll") for (int _i = 0; _i < 2; ++_i) \
        __builtin_amdgcn_global_load_lds((const unsigned*)((const char*)(gbase) + (voff)[_i]), (PG8_LAS unsigned*)(lds + (bufoff) + ldsw + _i * 8192), 16, 0, 0); } while (0)
#define PG8_LDA(dst, b, h) do { _Pragma("unroll") for (int m = 0; m < 4; ++m) _Pragma("unroll") for (int k = 0; k < 2; ++k) dst[m][k] = *(const PG8_LAS bf16x8*)(lds + PG8_SA(b, h) + aoff + m * 2048 + k * 1024); } while (0)
#define PG8_LDB(dst, b, h) do { _Pragma("unroll") for (int n = 0; n < 2; ++n) _Pragma("unroll") for (int k = 0; k < 2; ++k) dst[n][k] = *(const PG8_LAS bf16x8*)(lds + PG8_SB(b, h) + boff + n * 2048 + k * 1024); } while (0)
#define PG8_MMA(ai, bj, At, Bt) do { __builtin_amdgcn_s_setprio(1); _Pragma("unroll") for (int m = 0; m < 4; ++m) _Pragma("unroll") for (int n = 0; n < 2; ++n) _Pragma("unroll") for (int k = 0; k < 2; ++k) \
        acc[ai][bj][m][n] = __builtin_amdgcn_mfma_f32_16x16x32_bf16(Bt[n][k], At[m][k], acc[ai][bj][m][n], 0, 0, 0); __builtin_amdgcn_s_setprio(0); } while (0)
#define PG8_WAIT_V(n) asm volatile("s_waitcnt vmcnt(" #n ")" ::: "memory")
#define PG8_WAIT_L(n) asm volatile("s_waitcnt lgkmcnt(" #n ")" ::: "memory")
#define PG8_BAR __builtin_amdgcn_s_barrier()
#define PG8_SCHED __builtin_amdgcn_sched_barrier(0)
    Unit cur, nxt; int ui = 0;
    if (!S.next(0, cur)) return;
    f32x4 acc[2][2][4][2];
#pragma unroll
    for (int a = 0; a < 2; ++a)
#pragma unroll
        for (int b = 0; b < 2; ++b)
#pragma unroll
            for (int m = 0; m < 4; ++m)
#pragma unroll
                for (int n = 0; n < 2; ++n) acc[a][b][m][n] = (f32x4){0.f, 0.f, 0.f, 0.f};
    bf16x8 At[4][2], B0[2][2], B1[2][2];
    const char* cA = (const char*)g.A + (size_t)cur.pm * tstep + cur.koff; const char* cB = (const char*)g.Bt + (size_t)cur.pn * tstep + cur.koff;
    S.a_ready(cur);
    if constexpr (SP2) {
        PG8_STAGE(PG8_SB(0, 0), cB, voffB); PG8_STAGE(PG8_SB(0, 1), cB + hstep, voffB); PG8_STAGE(PG8_SA(0, 0), cA, voffA); PG8_STAGE(PG8_SA(0, 1), cA + hstep, voffA);
        if (wr == 1) PG8_BAR;
        PG8_WAIT_V(2); PG8_BAR;
        PG8_STAGE(PG8_SB(1, 0), cB + kstep, voffB); PG8_STAGE(PG8_SA(1, 0), cA + kstep, voffA); PG8_STAGE(PG8_SB(1, 1), cB + hstep + kstep, voffB);
        PG8_WAIT_V(6); PG8_BAR;
    } else {
        PG8_STAGE(PG8_SB(0, 0), cB, voffB); PG8_STAGE(PG8_SA(0, 0), cA, voffA); PG8_STAGE(PG8_SB(0, 1), cB + hstep, voffB); PG8_STAGE(PG8_SA(0, 1), cA + hstep, voffA);
        if (wr == 1) PG8_BAR;
        PG8_WAIT_V(4); PG8_BAR;
        PG8_STAGE(PG8_SB(1, 0), cB + kstep, voffB); PG8_STAGE(PG8_SA(1, 0), cA + kstep, voffA); PG8_STAGE(PG8_SB(1, 1), cB + hstep + kstep, voffB);
        PG8_WAIT_V(6); PG8_BAR;
    }
    for (;;) {
        const bool has_next = S.next(ui + 1, nxt);
        const char* nA = has_next ? (const char*)g.A + (size_t)nxt.pm * tstep + nxt.koff : cA; const char* nB = has_next ? (const char*)g.Bt + (size_t)nxt.pn * tstep + nxt.koff : cB;
        const int nt = cur.nt;
        for (int t = 0; t < nt; t += 2) {
            const bool last = (t == nt - 2);
            const char* a1 = cA + (size_t)(t + 1) * kstep;
            const char* a2 = last ? nA : cA + (size_t)(t + 2) * kstep; const char* b2 = last ? nB : cB + (size_t)(t + 2) * kstep;
            const char* a3 = a2 + kstep; const char* b3 = b2 + kstep;
            if (last && has_next) S.a_ready(nxt);
            if constexpr (SP2) {
            PG8_LDB(B0, 0, 0); PG8_LDB(B1, 0, 1); PG8_SCHED; PG8_LDA(At, 0, 0); PG8_STAGE(PG8_SA(1, 1), a1 + hstep, voffA);
            PG8_WAIT_V(8); PG8_WAIT_L(0); PG8_BAR; PG8_MMA(0, 0, At, B0); PG8_MMA(0, 1, At, B1); PG8_BAR; PG8_SCHED;
            PG8_LDA(At, 0, 1); PG8_STAGE(PG8_SB(0, 0), b2, voffB); PG8_STAGE(PG8_SB(0, 1), b2 + hstep, voffB); PG8_STAGE(PG8_SA(0, 0), a2, voffA);
            PG8_WAIT_V(8); PG8_WAIT_L(0); PG8_BAR; PG8_MMA(1, 0, At, B0); PG8_MMA(1, 1, At, B1); PG8_BAR; PG8_SCHED;
            PG8_LDB(B0, 1, 0); PG8_LDB(B1, 1, 1); PG8_SCHED; PG8_LDA(At, 1, 0); PG8_STAGE(PG8_SA(0, 1), a2 + hstep, voffA);
            PG8_WAIT_V(8); PG8_WAIT_L(0); PG8_BAR; PG8_MMA(0, 0, At, B0); PG8_MMA(0, 1, At, B1); PG8_BAR; PG8_SCHED;
            PG8_LDA(At, 1, 1); PG8_STAGE(PG8_SB(1, 0), b3, voffB); PG8_STAGE(PG8_SB(1, 1), b3 + hstep, voffB); PG8_STAGE(PG8_SA(1, 0), a3, voffA);
            PG8_WAIT_V(8); PG8_WAIT_L(0); PG8_BAR; PG8_MMA(1, 0, At, B0); PG8_MMA(1, 1, At, B1); PG8_BAR; PG8_SCHED;
            } else {
            PG8_LDB(B0, 0, 0); PG8_SCHED; PG8_LDA(At, 0, 0); PG8_STAGE(PG8_SA(1, 1), a1 + hstep, voffA);
            PG8_WAIT_L(8); PG8_BAR; PG8_WAIT_L(0); PG8_MMA(0, 0, At, B0); PG8_BAR; PG8_SCHED;
            PG8_LDB(B1, 0, 1); PG8_STAGE(PG8_SB(0, 0), b2, voffB);
            PG8_BAR; PG8_WAIT_L(0); PG8_MMA(0, 1, At, B1); PG8_BAR;
            PG8_LDA(At, 0, 1); PG8_STAGE(PG8_SA(0, 0), a2, voffA);
            PG8_BAR; PG8_WAIT_L(0); PG8_MMA(1, 0, At, B0); PG8_BAR; PG8_SCHED;
            PG8_STAGE(PG8_SB(0, 1), b2 + hstep, voffB);
            PG8_WAIT_V(6); PG8_BAR; PG8_MMA(1, 1, At, B1); PG8_BAR;
            PG8_LDB(B0, 1, 0); PG8_SCHED; PG8_LDA(At, 1, 0); PG8_STAGE(PG8_SA(0, 1), a2 + hstep, voffA);
            PG8_WAIT_L(8); PG8_BAR; PG8_WAIT_L(0); PG8_MMA(0, 0, At, B0); PG8_BAR; PG8_SCHED;
            PG8_LDB(B1, 1, 1); PG8_STAGE(PG8_SB(1, 0), b3, voffB);
            PG8_BAR; PG8_WAIT_L(0); PG8_MMA(0, 1, At, B1); PG8_BAR;
            PG8_LDA(At, 1, 1); PG8_STAGE(PG8_SA(1, 0), a3, voffA);
            PG8_BAR; PG8_WAIT_L(0); PG8_MMA(1, 0, At, B0); PG8_BAR; PG8_SCHED;
            PG8_STAGE(PG8_SB(1, 1), b3 + hstep, voffB);
            PG8_WAIT_V(6); PG8_BAR; PG8_MMA(1, 1, At, B1); PG8_BAR;
            }
        }
        if constexpr (ALIGN_EPI) { if (wr == 0) PG8_BAR; }
        if constexpr (!Epi::AFTER_DRAIN) { E(acc, cur, wr, wc, fr, fq); S.done(cur); }
        if (!has_next) break;
        if (!Epi::keep_acc(nxt)) {
#pragma unroll
        for (int a = 0; a < 2; ++a)
#pragma unroll
            for (int b = 0; b < 2; ++b)
#pragma unroll
                for (int m = 0; m < 4; ++m)
#pragma unroll
                    for (int n = 0; n < 2; ++n) acc[a][b][m][n] = (f32x4){0.f, 0.f, 0.f, 0.f};
        }
        cur = nxt; cA = nA; cB = nB; ++ui;
        if constexpr (ALIGN_EPI) { if (wr == 1) PG8_BAR; }
    }
    PG8_WAIT_V(0);
    if constexpr (!ALIGN_EPI) { if (wr == 0) PG8_BAR; }
    PG8_BAR;
    if constexpr (Epi::AFTER_DRAIN) { E.fused(acc, cur, wr, wc, fr, fq, lds, wid, lane); S.done(cur); }
#undef PG8_SA
#undef PG8_SB
#undef PG8_STAGE
#undef PG8_LDA
#undef PG8_LDB
#undef PG8_MMA
#undef PG8_WAIT_V
#undef PG8_WAIT_L
#undef PG8_BAR
#undef PG8_SCHED
}
}

#define LAS __attribute__((address_space(3)))
typedef unsigned short bf16_t;
typedef short bf16x8 __attribute__((ext_vector_type(8)));
typedef short s16x4 __attribute__((ext_vector_type(4)));
typedef float f32x4 __attribute__((ext_vector_type(4)));
typedef float f32x16 __attribute__((ext_vector_type(16)));
typedef unsigned u32x4 __attribute__((ext_vector_type(4)));
typedef unsigned u32x2 __attribute__((ext_vector_type(2)));
typedef float f32x2_t __attribute__((ext_vector_type(2)));
typedef __bf16 bf16x2_t __attribute__((ext_vector_type(2)));

constexpr int DM = 1024, NBATCH = 8, SEQ = 2048, DEPTH = 4, CTXL = 256;
constexpr int ML = NBATCH * SEQ, MC = NBATCH * CTXL, MT = ML + MC;
constexpr int INC = 6656, ZC = 1536, GCOLS = 3072, DFF = 4096;
constexpr int KVT = 2304, KVROW = 256;
constexpr int NMT = MT / 256;
constexpr size_t MiB = (size_t)1 << 20;
constexpr size_t WS_WIN = 0, WS_WBR = 13 * MiB, WS_WOUT = 16 * MiB, WS_W1 = 18 * MiB, WS_W2 = 26 * MiB, WS_XC = 34 * MiB,
                 WS_MOD = 42 * MiB, WS_ROPE = 43 * MiB, WS_CTL = 43 * MiB + 512 * 1024, WS_A3 = 44 * MiB, WS_Z1 = 98 * MiB, WS_G = 224 * MiB, WS_PART = 332 * MiB, WS_WSET1 = 396 * MiB, WS_END = 430 * MiB;
constexpr size_t WS_HN = WS_A3, WS_KVD = WS_Z1 + 54 * MiB, WS_KVN = WS_Z1 + 90 * MiB, WS_MB = WS_Z1 + 72 * MiB, WS_H = WS_Z1;
constexpr int LDS_BYTES = 155648;
constexpr float LOG2E = 1.4426950408889634f;

struct Params {
    const float *x, *c, *ctx, *c_ctx, *w_ada, *b_ada, *g_mix, *g_mlp, *w_in, *lq1, *lk1, *lq2, *lk2, *g_subln, *pool_w, *pool_scale,
                *nat_rpb, *w_branch, *w_out, *w_mlp1, *w_mlp2, *g_final;
    float* out; unsigned char* ws;
};

__device__ __forceinline__ unsigned cvtpk(float lo, float hi) { f32x2_t v = {lo, hi}; bf16x2_t b = __builtin_convertvector(v, bf16x2_t); return __builtin_bit_cast(unsigned, b); }
__device__ __forceinline__ float bf2f(unsigned short v) { return __uint_as_float((unsigned)v << 16); }
__device__ __forceinline__ float wave_sum(float v) {
#pragma unroll
    for (int o = 1; o < 64; o <<= 1) v += __shfl_xor(v, o);
    return v;
}
__device__ __forceinline__ float* xrow_ptr(const Params& p, int row) { return row < ML ? p.out + (size_t)row * DM : (float*)(p.ws + WS_XC) + (size_t)(row - ML) * DM; }

#define XB_TMO      128
#define XB_XCNT(j)  (256  + 64 * (j))
#define XB_XSUB(j)  (1280 + 64 * (j))
#define XB_XGEN(j)  (2304 + 64 * (j))
#define XB_TOP      3328
#define XB_TOPGEN   3392
#define XCD_BAR_WORDS 3456
#define XB_SPIN_CAP (1u << 18)

__device__ __forceinline__ unsigned xb_ld(unsigned* p)              { return __hip_atomic_load(p, __ATOMIC_RELAXED, __HIP_MEMORY_SCOPE_AGENT); }
__device__ __forceinline__ unsigned xb_add(unsigned* p, unsigned v) { return __hip_atomic_fetch_add(p, v, __ATOMIC_RELAXED, __HIP_MEMORY_SCOPE_AGENT); }
__device__ __forceinline__ unsigned xb_xcc_id() { return (unsigned)__builtin_amdgcn_s_getreg((3 << 11) | 20) & 0xFu; }
#define XB_SPIN(cond, bar) do { unsigned _sp = 0; while (cond) { __builtin_amdgcn_s_sleep(1); \
    if ((++_sp & 255u) == 0u) { if (xb_ld(&(bar)[XB_TMO])) break; if (_sp > XB_SPIN_CAP) { atomicAdd(&(bar)[XB_TMO], 1u); break; } } } } while (0)

struct XcdBarrier {
    unsigned* bar; unsigned x;
    volatile LAS unsigned* st;
};

__device__ __forceinline__ XcdBarrier xcd_barrier_post(unsigned* bar, volatile LAS unsigned* st) {
    XcdBarrier b; b.bar = bar; b.x = xb_xcc_id(); b.st = st;
    if (threadIdx.x == 0) (void)xb_add(&bar[XB_XCNT(b.x)], 1u);
    return b;
}
__device__ __forceinline__ void xcd_barrier_complete(unsigned* bar, unsigned x, unsigned& nloc, unsigned& nx) {
    const unsigned G = gridDim.x * gridDim.y * gridDim.z;
    unsigned sum, cnt, mine, sp = 0u;
    for (;;) {
        sum = 0u; cnt = 0u; mine = 0u;
#pragma unroll
        for (unsigned j = 0; j < 16; ++j) { const unsigned c = xb_ld(&bar[XB_XCNT(j)]); sum += c; cnt += (c > 0u) ? 1u : 0u; mine = (j == x) ? c : mine; }
        if (sum == G) break;
        __builtin_amdgcn_s_sleep(1);
        if ((++sp & 255u) == 0u) { if (xb_ld(&bar[XB_TMO])) break; if (sp > XB_SPIN_CAP) { atomicAdd(&bar[XB_TMO], 1u); break; } }
    }
    nloc = mine > 0u ? mine : 1u; nx = cnt > 0u ? cnt : 1u;
}

__device__ __forceinline__ void xcd_barrier(const XcdBarrier& b) {
    asm volatile("s_waitcnt vmcnt(0)" ::: "memory");
    __syncthreads();
    if (threadIdx.x == 0) {
        unsigned* bar = b.bar;
        __builtin_amdgcn_s_waitcnt(0);
        unsigned nloc = b.st[0], nx = b.st[1];
        if (nloc == 0u) { xcd_barrier_complete(bar, b.x, nloc, nx); b.st[0] = nloc; b.st[1] = nx; }
        const unsigned old = xb_add(&bar[XB_XSUB(b.x)], 1u);
        const unsigned gen = old / nloc;
        if (old + 1u == (gen + 1u) * nloc) {
            __builtin_amdgcn_fence(__ATOMIC_RELEASE, "agent");
            asm volatile("s_waitcnt vmcnt(0)" ::: "memory");
            const unsigned og = xb_add(&bar[XB_TOP], 1u);
            const unsigned tg = og / nx;
            if (og + 1u == (tg + 1u) * nx) xb_add(&bar[XB_TOPGEN], 1u);
            else XB_SPIN(xb_ld(&bar[XB_TOPGEN]) == tg, bar);
            __builtin_amdgcn_fence(__ATOMIC_ACQUIRE, "agent");
            xb_add(&bar[XB_XGEN(b.x)], 1u);
            asm volatile("s_waitcnt vmcnt(0)" ::: "memory");
        } else {
            XB_SPIN(xb_ld(&bar[XB_XGEN(b.x)]) == gen, bar);
            __builtin_amdgcn_fence(__ATOMIC_ACQUIRE, "agent");
            asm volatile("s_waitcnt vmcnt(0)" ::: "memory");
        }
    }
    __syncthreads();
}

struct EpiInProj {
    static constexpr bool PERM = true, AFTER_DRAIN = false;
    static __device__ __forceinline__ bool keep_acc(const pg8::Unit&) { return false; }
    bf16_t* Z1; bf16_t* G; const float* rope; bf16_t* KVD; bf16_t* KVN;
    __device__ __forceinline__ void operator()(const f32x4 (&acc)[2][2][4][2], const pg8::Unit& u, int wr, int wc, int fr, int fq) const {
        const int pn = u.pn;
        if (pn < 14) {
            const bool rope_tile = pn < 4;
            const int kind = pn >> 1;
            const bool tokmajor = (kind == 0) || (kind == 3) || (kind == 4);
            const int zoff = (kind == 0 ? 0 : kind == 3 ? 512 : 1024) + (pn & 1) * 256;
            bf16_t* kvb = (kind <= 2 ? KVD : KVN) + ((kind == 2 || kind == 6) ? 128 : 0);
            f32x4 csq[16];
#pragma unroll
            for (int k = 0; k < 8; ++k) {
                const int row = u.pm * 256 + (k >> 2) * 128 + wr * 64 + (k & 3) * 16 + fr;
                if (rope_tile && row < ML) {
                    const int pos = (wc & 1) ? (row & 63) : ((row >> 6) & 31);
                    const f32x4* t = (const f32x4*)(rope + pos * 32 + fq * 8);
                    csq[2 * k] = t[0]; csq[2 * k + 1] = t[1];
                } else { csq[2 * k] = (f32x4){1.f, 0.f, 1.f, 0.f}; csq[2 * k + 1] = (f32x4){1.f, 0.f, 1.f, 0.f}; }
            }
            __builtin_amdgcn_sched_barrier(0);
#pragma unroll
            for (int ai = 0; ai < 2; ++ai)
#pragma unroll
                for (int m = 0; m < 4; ++m) {
                    const int row = u.pm * 256 + ai * 128 + wr * 64 + m * 16 + fr;
                    const f32x4 cs0 = csq[2 * (ai * 4 + m)], cs1 = csq[2 * (ai * 4 + m) + 1];
                    const int bb = row < ML ? (row >> 11) : ((row - ML) >> 8), tt = row < ML ? 256 + (row & 2047) : ((row - ML) & 255);
                    bf16_t* rp = tokmajor ? Z1 + (size_t)row * ZC + zoff + wc * 32 + fq * 8
                                          : kvb + ((size_t)(bb * 4 + (pn & 1) * 2) * KVT + tt) * KVROW + wc * 32 + fq * 8;
                    const size_t bjs = tokmajor ? (size_t)128 : (size_t)KVT * KVROW;
#pragma unroll
                    for (int bj = 0; bj < 2; ++bj) {
                        const f32x4 u1 = acc[ai][bj][m][0], u2 = acc[ai][bj][m][1];
                        f32x4 n1, n2;
                        n1[0] = u1[0] * cs0[0] - u2[0] * cs0[1]; n2[0] = u1[0] * cs0[1] + u2[0] * cs0[0];
                        n1[1] = u1[1] * cs0[2] - u2[1] * cs0[3]; n2[1] = u1[1] * cs0[3] + u2[1] * cs0[2];
                        n1[2] = u1[2] * cs1[0] - u2[2] * cs1[1]; n2[2] = u1[2] * cs1[1] + u2[2] * cs1[0];
                        n1[3] = u1[3] * cs1[2] - u2[3] * cs1[3]; n2[3] = u1[3] * cs1[3] + u2[3] * cs1[2];
                        u32x4 w_; w_.x = cvtpk(n1[0], n1[1]); w_.y = cvtpk(n1[2], n1[3]); w_.z = cvtpk(n2[0], n2[1]); w_.w = cvtpk(n2[2], n2[3]);
                        *(u32x4*)(rp + bj * bjs) = w_;
                    }
                }
        } else {
            const int sub = (pn - 14) >> 2, pn4 = (pn - 14) & 3;
            bf16_t* gp = G + ((((size_t)(sub * NMT + u.pm) * 4 + pn4) * 8 + (wr * 4 + wc)) * 64 + (fq * 16 + fr)) * 128;
#pragma unroll
            for (int ai = 0; ai < 2; ++ai)
#pragma unroll
                for (int m = 0; m < 4; ++m)
#pragma unroll
                    for (int bj = 0; bj < 2; ++bj) {
                        f32x4 s0v, s1v; const f32x4 v0 = acc[ai][bj][m][0], v1 = acc[ai][bj][m][1];
#pragma unroll
                        for (int e = 0; e < 4; ++e) { s0v[e] = __builtin_amdgcn_rcpf(1.0f + __expf(-v0[e])); s1v[e] = __builtin_amdgcn_rcpf(1.0f + __expf(-v1[e])); }
                        u32x4 w; w.x = cvtpk(s0v[0], s0v[1]); w.y = cvtpk(s0v[2], s0v[3]); w.z = cvtpk(s1v[0], s1v[1]); w.w = cvtpk(s1v[2], s1v[3]);
                        *(u32x4*)(gp + ((ai * 4 + m) * 2 + bj) * 8) = w;
                    }
        }
    }
};

struct EpiBranch {
    static constexpr bool PERM = true, AFTER_DRAIN = false;
    static __device__ __forceinline__ bool keep_acc(const pg8::Unit& nxt) { return (nxt.pn >> 2) != 0; }
    const bf16_t* G; bf16_t* MB;
    __device__ __forceinline__ void operator()(f32x4 (&acc)[2][2][4][2], const pg8::Unit& u, int wr, int wc, int fr, int fq) const {
        const int sub = u.pn >> 2, pn = u.pn & 3, pm = u.pm - sub * NMT;
        constexpr size_t SUBSTRIDE = (size_t)NMT * 4 * 8 * 64 * 128;
        const bf16_t* gp = G + ((((size_t)(sub * NMT + pm) * 4 + pn) * 8 + (wr * 4 + wc)) * 64 + (fq * 16 + fr)) * 128;
#define UNPK_LO(w) __uint_as_float((w) << 16)
#define UNPK_HI(w) __uint_as_float((w) & 0xffff0000u)
#pragma unroll
        for (int ai = 0; ai < 2; ++ai) {
            u32x4 gw[8], hw[8];
#pragma unroll
            for (int k = 0; k < 8; ++k) gw[k] = *(const u32x4*)(gp + (ai * 8 + k) * 8);
            if (sub < 2) {
#pragma unroll
                for (int k = 0; k < 8; ++k) hw[k] = *(const u32x4*)(gp + SUBSTRIDE + (ai * 8 + k) * 8);
            }
            __builtin_amdgcn_sched_barrier(0);
#pragma unroll
            for (int m = 0; m < 4; ++m)
#pragma unroll
                for (int bj = 0; bj < 2; ++bj) {
                    const u32x4 g_ = gw[m * 2 + bj];
                    f32x4 g0 = {UNPK_LO(g_.x), UNPK_HI(g_.x), UNPK_LO(g_.y), UNPK_HI(g_.y)}, g1 = {UNPK_LO(g_.z), UNPK_HI(g_.z), UNPK_LO(g_.w), UNPK_HI(g_.w)};
                    if (sub < 2) {
                        const u32x4 h_ = hw[m * 2 + bj];
                        const f32x4 h0 = {UNPK_LO(h_.x), UNPK_HI(h_.x), UNPK_LO(h_.y), UNPK_HI(h_.y)}, h1 = {UNPK_LO(h_.z), UNPK_HI(h_.z), UNPK_LO(h_.w), UNPK_HI(h_.w)};
#pragma unroll
                        for (int e2 = 0; e2 < 4; ++e2) { acc[ai][bj][m][0][e2] *= g0[e2] * __builtin_amdgcn_rcpf(h0[e2]); acc[ai][bj][m][1][e2] *= g1[e2] * __builtin_amdgcn_rcpf(h1[e2]); }
                    } else {
                        const int row = pm * 256 + ai * 128 + wr * 64 + m * 16 + fr, col0 = pn * 256 + wc * 32 + fq * 8;
                        const f32x4 v0 = acc[ai][bj][m][0] * g0, v1 = acc[ai][bj][m][1] * g1;
                        u32x4 w_; w_.x = cvtpk(v0[0], v0[1]); w_.y = cvtpk(v0[2], v0[3]); w_.z = cvtpk(v1[0], v1[1]); w_.w = cvtpk(v1[2], v1[3]);
                        *(u32x4*)(MB + (size_t)row * DM + col0 + bj * 128) = w_;
                    }
                }
            __builtin_amdgcn_sched_barrier(0);
        }
#undef UNPK_LO
#undef UNPK_HI
    }
};
struct BranchOrder {
    int nctx_tiles, G, c;
    __device__ __forceinline__ bool next(int i, pg8::Unit& u) const {
        const int t = i / 3, sub = i - 3 * t, x = c & 7, sl = c >> 3;
        bool ok; int pm, pn;
        if (G == 256) { ok = (t == 0) || (t == 1 && nctx_tiles > 0 && sl < 4); pm = t == 0 ? x + 8 * (sl >> 2) : 64 + x; pn = sl & 3; }
        else { const long L = (long)t * G + c; ok = L < 256 + nctx_tiles; pm = (int)(L >> 2); pn = (int)(L & 3); }
        u.pm = sub * NMT + pm; u.pn = sub * 4 + pn; u.koff = 0; u.nt = 8; u.ks = 0; return ok;
    }
    __device__ __forceinline__ void a_ready(const pg8::Unit&) const {}
    __device__ __forceinline__ void done(const pg8::Unit&) const {}
};

struct InProjOrder {
    pg8::StaticOrder lat, ctxo; int G, c, full;
    __device__ __forceinline__ void init(int G_, int c_, int full_) { lat.init(ML, INC, G_, c_, DM); ctxo.init(MC, INC, G_, c_, DM); G = G_; c = c_; full = full_; }
    __device__ __forceinline__ bool next(int i, pg8::Unit& u) const {
        const long L = (long)i * G + c;
        const int nlat = 64 * 26;
        pg8::Unit a; a.pm = 0; a.pn = 0; a.koff = 0; a.nt = 16; a.ks = 0;
        const bool islat = L < nlat;
        (void)lat.next(islat ? i : 0, a);
        const int k = (int)(L - nlat);
        const int nctx = full ? 8 * 26 : 8 * 8;
        int cpm, cpn;
        if (full) { cpm = k / 26; cpn = k - cpm * 26; } else { cpm = k >> 3; const int t = k & 7; cpn = t < 4 ? 2 + t : 6 + t; }
        u.pm = islat ? a.pm : 64 + cpm; u.pn = islat ? a.pn : cpn; u.koff = 0; u.nt = 16; u.ks = 0;
        return islat ? true : (k < nctx);
    }
    __device__ __forceinline__ void a_ready(const pg8::Unit&) const {}
    __device__ __forceinline__ void done(const pg8::Unit&) const {}
};

struct SplitOrder {
    pg8::StaticOrder lat; int G, c, nlat, K, split;
    __device__ __forceinline__ void init(int G_, int c_, int K_, int split_) { lat.init(ML, DM, G_, c_, K_); G = G_; c = c_; K = K_; split = split_; nlat = c_ < 256 ? (256 - c_ + G_ - 1) / G_ : 0; }
    __device__ __forceinline__ bool next(int i, pg8::Unit& u) const {
        const bool islat = i < nlat;
        pg8::Unit a; a.pm = 0; a.pn = 0; a.koff = 0; a.nt = 2; a.ks = 0;
        const bool oka = lat.next(islat ? i : 0, a);
        const int q = (i - nlat) * G + c, unit = q >> 3, ks = q & 7;
        const bool okp = split && q < 256;
        u.pm = islat ? a.pm : 64 + (unit >> 2); u.pn = islat ? a.pn : (unit & 3); u.nt = islat ? a.nt : K / 512; u.koff = islat ? 0 : ks * (K / 8) * 2; u.ks = islat ? 0 : ks;
        return islat ? oka : okp;
    }
    __device__ __forceinline__ void a_ready(const pg8::Unit&) const {}
    __device__ __forceinline__ void done(const pg8::Unit&) const {}
};

struct EpiResid {
    static constexpr bool PERM = false, AFTER_DRAIN = false;
    static __device__ __forceinline__ bool keep_acc(const pg8::Unit&) { return false; }
    const float* xsrc; float* xl; float* part; const float* mod; int gi;
    __device__ __forceinline__ void operator()(const f32x4 (&acc)[2][2][4][2], const pg8::Unit& u, int wr, int wc, int fr, int fq) const {
        const int bidx = u.pm < 64 ? (u.pm >> 3) : 8;
        const float* gate = mod + (size_t)bidx * 6144 + gi * 1024;
        const int col0 = u.pn * 256 + wc * 32 + fq * 4;
        const int row0 = u.pm * 256 + wr * 64 + fr;
        const bool lat = u.pm < 64;
        float* base = lat ? xl + (size_t)row0 * DM + col0 : part + ((size_t)u.ks * MC + (size_t)(row0 - ML)) * DM + col0;
        const float* rsrc = xsrc + (size_t)row0 * DM + col0;
#pragma unroll
        for (int bj = 0; bj < 2; ++bj) {
            f32x4 gv[2], xv[16];
#pragma unroll
            for (int n = 0; n < 2; ++n) gv[n] = *(const f32x4*)(gate + col0 + bj * 128 + n * 16);
#pragma unroll
            for (int n = 0; n < 2; ++n)
#pragma unroll
                for (int k = 0; k < 8; ++k) xv[n * 8 + k] = lat ? *(const f32x4*)(rsrc + (size_t)((k >> 2) * 128 + (k & 3) * 16) * DM + bj * 128 + n * 16) : (f32x4){0.f, 0.f, 0.f, 0.f};
            __builtin_amdgcn_sched_barrier(0);
#pragma unroll
            for (int n = 0; n < 2; ++n)
#pragma unroll
                for (int ai = 0; ai < 2; ++ai)
#pragma unroll
                    for (int m = 0; m < 4; ++m) {
                        const size_t off = (size_t)(ai * 128 + m * 16) * DM + bj * 128 + n * 16;
                        *(f32x4*)(base + off) = gv[n] * acc[ai][bj][m][n] + xv[n * 8 + ai * 4 + m];
                    }
            __builtin_amdgcn_sched_barrier(0);
        }
    }
};
struct EpiMlp1 {
    static constexpr bool PERM = true, AFTER_DRAIN = false;
    static __device__ __forceinline__ bool keep_acc(const pg8::Unit&) { return false; }
    bf16_t* H;
    __device__ __forceinline__ void operator()(const f32x4 (&acc)[2][2][4][2], const pg8::Unit& u, int wr, int wc, int fr, int fq) const {
        const int col0 = u.pn * 256 + wc * 32 + fq * 8;
#pragma unroll
        for (int ai = 0; ai < 2; ++ai)
#pragma unroll
            for (int m = 0; m < 4; ++m) {
                const int row = u.pm * 256 + ai * 128 + wr * 64 + m * 16 + fr;
                bf16_t* rp = H + (size_t)row * DFF + col0;
#pragma unroll
                for (int bj = 0; bj < 2; ++bj) {
                    f32x4 v0 = acc[ai][bj][m][0], v1 = acc[ai][bj][m][1];
#pragma unroll
                    for (int e = 0; e < 4; ++e) { const float r0 = fmaxf(v0[e], 0.f), r1 = fmaxf(v1[e], 0.f); v0[e] = r0 * r0; v1[e] = r1 * r1; }
                    u32x4 w; w.x = cvtpk(v0[0], v0[1]); w.y = cvtpk(v0[2], v0[3]); w.z = cvtpk(v1[0], v1[1]); w.w = cvtpk(v1[2], v1[3]);
                    *(u32x4*)(rp + bj * 128) = w;
                }
            }
    }
};

namespace att {
constexpr int KPB = 272, VPB = 320;
constexpr int KBUF = 64 * KPB, VBUF = 64 * VPB;
constexpr int OFF_K = 0, OFF_V = 2 * KBUF, OFF_RPB = OFF_V + 2 * VBUF;
typedef short v4i16_t __attribute__((ext_vector_type(4)));

struct TileRegs { u32x4 r[4]; };
__device__ __forceinline__ void tile_load(TileRegs& R, const bf16_t* KVb, int trow0, int tid) {
    const bf16_t* src = KVb + (size_t)trow0 * KVROW + tid * 8;
#pragma unroll
    for (int i = 0; i < 4; ++i) R.r[i] = *(const u32x4*)(src + i * 4096);
}
__device__ __forceinline__ void tile_store(const TileRegs& R, LAS unsigned char* Kb, LAS unsigned char* Vb, int tid) {
    const int ch = tid & 31, row = tid >> 5;
    LAS unsigned char* d = ch < 16 ? Kb + row * KPB + ch * 16 : Vb + row * VPB + (ch - 16) * 16;
    const int step = ch < 16 ? 16 * KPB : 16 * VPB;
#pragma unroll
    for (int i = 0; i < 4; ++i) *(LAS u32x4*)(d + i * step) = R.r[i];
}
__device__ __forceinline__ bf16x8 pack8(const f32x16& s, int b) {
    u32x4 w; w.x = cvtpk(s[b], s[b + 1]); w.y = cvtpk(s[b + 2], s[b + 3]); w.z = cvtpk(s[b + 4], s[b + 5]); w.w = cvtpk(s[b + 6], s[b + 7]);
    return __builtin_bit_cast(bf16x8, w);
}
template <int NDV, int MODE>
__device__ __forceinline__ void attn_qks(LAS const unsigned char* Kt, const bf16x8 (&qf)[4], f32x16 (&o)[NDV], f32x16& lacc, float& m, bf16x8 (&pf)[4],
                                         int r32, int hi, LAS const float* brow, int qc, int cs) {
    bf16x8 kf[8];
#pragma unroll
    for (int ks = 0; ks < 4; ++ks) {
        kf[2 * ks] = *(LAS const bf16x8*)(Kt + r32 * KPB + ks * 32 + hi * 16);
        kf[2 * ks + 1] = *(LAS const bf16x8*)(Kt + (32 + r32) * KPB + ks * 32 + hi * 16);
    }
    float bq0[16], bq1[16];
    if (MODE == 1) {
#pragma unroll
        for (int r = 0; r < 16; ++r) {
            const int kc0 = (r & 3) + 8 * (r >> 2) + 4 * hi, kc1 = kc0 + 32;
            const bool v0 = (unsigned)(kc0 - cs) < 16u, v1 = (unsigned)(kc1 - cs) < 16u;
            bq0[r] = brow[v0 ? (kc0 - qc + 15) : 0]; bq1[r] = brow[v1 ? (kc1 - qc + 15) : 0];
        }
    }
    __builtin_amdgcn_sched_barrier(0);
    f32x16 s0, s1;
#pragma unroll
    for (int r = 0; r < 16; ++r) { s0[r] = 0.f; s1[r] = 0.f; }
#pragma unroll
    for (int ks = 0; ks < 4; ++ks) {
        s0 = __builtin_amdgcn_mfma_f32_32x32x16_bf16(kf[2 * ks], qf[ks], s0, 0, 0, 0);
        s1 = __builtin_amdgcn_mfma_f32_32x32x16_bf16(kf[2 * ks + 1], qf[ks], s1, 0, 0, 0);
    }
    __builtin_amdgcn_sched_barrier(0);
    constexpr float C = 0.125f * LOG2E;
    if (MODE == 1) {
#pragma unroll
        for (int r = 0; r < 16; ++r) {
            const int kc0 = (r & 3) + 8 * (r >> 2) + 4 * hi, kc1 = kc0 + 32;
            const bool v0 = (unsigned)(kc0 - cs) < 16u, v1 = (unsigned)(kc1 - cs) < 16u;
            s0[r] = v0 ? __builtin_fmaf(s0[r], C, bq0[r] * LOG2E) : -1e30f;
            s1[r] = v1 ? __builtin_fmaf(s1[r], C, bq1[r] * LOG2E) : -1e30f;
        }
    }
    float mx = __builtin_fmaxf(s0[0], s1[0]);
#pragma unroll
    for (int r = 1; r < 16; ++r) mx = __builtin_fmaxf(__builtin_fmaxf(mx, s0[r]), s1[r]);
    if (MODE == 0) mx *= C;
    mx = __builtin_fmaxf(mx, __shfl_xor(mx, 32));
    if (__any(mx > m + 8.0f)) {
        const float mn = __builtin_fmaxf(m, mx);
        const float alpha = __builtin_amdgcn_exp2f(m - mn);
        m = mn;
        lacc[0] *= alpha;
#pragma unroll
        for (int d0 = 0; d0 < NDV; ++d0)
#pragma unroll
            for (int r = 0; r < 16; ++r) o[d0][r] *= alpha;
    }
    const float nm = -m;
#pragma unroll
    for (int r = 0; r < 16; ++r) {
        if (MODE == 0) { s0[r] = __builtin_amdgcn_exp2f(__builtin_fmaf(s0[r], C, nm)); s1[r] = __builtin_amdgcn_exp2f(__builtin_fmaf(s1[r], C, nm)); }
        else { s0[r] = __builtin_amdgcn_exp2f(s0[r] + nm); s1[r] = __builtin_amdgcn_exp2f(s1[r] + nm); }
    }
    pf[0] = pack8(s0, 0); pf[1] = pack8(s0, 8); pf[2] = pack8(s1, 0); pf[3] = pack8(s1, 8);
}
template <int NDV>
__device__ __forceinline__ void attn_pv(LAS const unsigned char* Vt, const bf16x8 (&pf)[4], f32x16 (&o)[NDV], f32x16& lacc, int vlane) {
    const bf16x8 ones = {0x3F80, 0x3F80, 0x3F80, 0x3F80, 0x3F80, 0x3F80, 0x3F80, 0x3F80};
#pragma unroll
    for (int dp = 0; dp < NDV; dp += 2) {
        bf16x8 vq[8];
#pragma unroll
        for (int d0 = 0; d0 < 2; ++d0)
#pragma unroll
            for (int s = 0; s < 4; ++s) {
                LAS const unsigned char* vp = Vt + vlane + s * 16 * VPB + (dp + d0) * 64;
                const v4i16_t lo = __builtin_amdgcn_ds_read_tr16_b64_v4i16((LAS v4i16_t*)vp);
                const v4i16_t hh = __builtin_amdgcn_ds_read_tr16_b64_v4i16((LAS v4i16_t*)(vp + 8 * VPB));
                vq[d0 * 4 + s] = (bf16x8){lo[0], lo[1], lo[2], lo[3], hh[0], hh[1], hh[2], hh[3]};
            }
        __builtin_amdgcn_sched_barrier(0);
        if (dp == 0) {
#pragma unroll
            for (int s = 0; s < 4; ++s) lacc = __builtin_amdgcn_mfma_f32_32x32x16_bf16(ones, pf[s], lacc, 0, 0, 0);
        }
#pragma unroll
        for (int s = 0; s < 4; ++s) {
            o[dp] = __builtin_amdgcn_mfma_f32_32x32x16_bf16(vq[s], pf[s], o[dp], 0, 0, 0);
            o[dp + 1] = __builtin_amdgcn_mfma_f32_32x32x16_bf16(vq[4 + s], pf[s], o[dp + 1], 0, 0, 0);
        }
        __builtin_amdgcn_sched_barrier(0);
    }
}
#define ATT_BAR() asm volatile("s_waitcnt lgkmcnt(0)\n\ts_barrier" ::: "memory")

#define ATT_SB() __builtin_amdgcn_sched_barrier(0)
constexpr int OFF3_K = 0, OFF3_V = 3 * KBUF, OFF3_Q = 3 * KBUF + 3 * VBUF;
__device__ __forceinline__ bf16x8 vfrag(LAS const unsigned char* vp) {
    const v4i16_t lo = __builtin_amdgcn_ds_read_tr16_b64_v4i16((LAS v4i16_t*)vp);
    const v4i16_t hh = __builtin_amdgcn_ds_read_tr16_b64_v4i16((LAS v4i16_t*)(vp + 8 * VPB));
    return (bf16x8){lo[0], lo[1], lo[2], lo[3], hh[0], hh[1], hh[2], hh[3]};
}
__device__ __forceinline__ void st_qk(LAS const unsigned char* Kt, LAS const unsigned char* Qt, f32x16& s0, f32x16& s1, int r32, int hi) {
    bf16x8 ka[4], qa[2];
#pragma unroll
    for (int ks = 0; ks < 2; ++ks) {
        ka[2 * ks] = *(LAS const bf16x8*)(Kt + r32 * KPB + ks * 32 + hi * 16);
        ka[2 * ks + 1] = *(LAS const bf16x8*)(Kt + (32 + r32) * KPB + ks * 32 + hi * 16);
        qa[ks] = *(LAS const bf16x8*)(Qt + r32 * KPB + ks * 32 + hi * 16);
    }
    ATT_SB();
#pragma unroll
    for (int r = 0; r < 16; ++r) { s0[r] = 0.f; s1[r] = 0.f; }
#pragma unroll
    for (int ks = 0; ks < 2; ++ks) {
        s0 = __builtin_amdgcn_mfma_f32_32x32x16_bf16(ka[2 * ks], qa[ks], s0, 0, 0, 0);
        s1 = __builtin_amdgcn_mfma_f32_32x32x16_bf16(ka[2 * ks + 1], qa[ks], s1, 0, 0, 0);
    }
    ATT_SB();
    bf16x8 kb[4], qb[2];
#pragma unroll
    for (int ks = 0; ks < 2; ++ks) {
        kb[2 * ks] = *(LAS const bf16x8*)(Kt + r32 * KPB + (ks + 2) * 32 + hi * 16);
        kb[2 * ks + 1] = *(LAS const bf16x8*)(Kt + (32 + r32) * KPB + (ks + 2) * 32 + hi * 16);
        qb[ks] = *(LAS const bf16x8*)(Qt + r32 * KPB + (ks + 2) * 32 + hi * 16);
    }
    ATT_SB();
#pragma unroll
    for (int ks = 0; ks < 2; ++ks) {
        s0 = __builtin_amdgcn_mfma_f32_32x32x16_bf16(kb[2 * ks], qb[ks], s0, 0, 0, 0);
        s1 = __builtin_amdgcn_mfma_f32_32x32x16_bf16(kb[2 * ks + 1], qb[ks], s1, 0, 0, 0);
    }
    ATT_SB();
}
__device__ __forceinline__ void st_softmax(f32x16& s0, f32x16& s1, f32x16 (&o)[4], float& lsum, float& m, bf16x8 (&pf)[4]) {
    constexpr float C = 0.125f * LOG2E;
    float mx = __builtin_fmaxf(s0[0], s1[0]);
#pragma unroll
    for (int r = 1; r < 16; ++r) mx = __builtin_fmaxf(__builtin_fmaxf(mx, s0[r]), s1[r]);
    mx *= C;
    mx = __builtin_fmaxf(mx, __shfl_xor(mx, 32));
    if (__any(mx > m + 8.0f)) {
        const float mn = __builtin_fmaxf(m, mx);
        const float alpha = __builtin_amdgcn_exp2f(m - mn);
        m = mn;
        lsum *= alpha;
#pragma unroll
        for (int d0 = 0; d0 < 4; ++d0)
#pragma unroll
            for (int r = 0; r < 16; ++r) o[d0][r] *= alpha;
    }
    const float nm = -m;
    float rs = 0.f;
#pragma unroll
    for (int r = 0; r < 16; ++r) { s0[r] = __builtin_amdgcn_exp2f(__builtin_fmaf(s0[r], C, nm)); s1[r] = __builtin_amdgcn_exp2f(__builtin_fmaf(s1[r], C, nm)); rs += s0[r] + s1[r]; }
    lsum += rs;
    pf[0] = pack8(s0, 0); pf[1] = pack8(s0, 8); pf[2] = pack8(s1, 0); pf[3] = pack8(s1, 8);
#pragma unroll
    for (int q_ = 0; q_ < 32; ++q_) { __builtin_amdgcn_sched_group_barrier(0x400, 1, 0); __builtin_amdgcn_sched_group_barrier(0x002, 3, 0); }
}
__device__ __forceinline__ void st_pv(LAS const unsigned char* Vt, const bf16x8 (&va)[4], const bf16x8 (&pf)[4], f32x16 (&o)[4], int vlane) {
    ATT_SB();
#pragma unroll
    for (int s = 0; s < 4; ++s) o[0] = __builtin_amdgcn_mfma_f32_32x32x16_bf16(va[s], pf[s], o[0], 0, 0, 0);
    ATT_SB();
    bf16x8 vb[4];
#pragma unroll
    for (int s = 0; s < 4; ++s) vb[s] = vfrag(Vt + vlane + s * 16 * VPB + 1 * 64);
    ATT_SB();
#pragma unroll
    for (int s = 0; s < 4; ++s) o[1] = __builtin_amdgcn_mfma_f32_32x32x16_bf16(vb[s], pf[s], o[1], 0, 0, 0);
    ATT_SB();
    bf16x8 vc[4];
#pragma unroll
    for (int s = 0; s < 4; ++s) vc[s] = vfrag(Vt + vlane + s * 16 * VPB + 2 * 64);
    ATT_SB();
#pragma unroll
    for (int s = 0; s < 4; ++s) o[2] = __builtin_amdgcn_mfma_f32_32x32x16_bf16(vc[s], pf[s], o[2], 0, 0, 0);
    ATT_SB();
    bf16x8 vd[4];
#pragma unroll
    for (int s = 0; s < 4; ++s) vd[s] = vfrag(Vt + vlane + s * 16 * VPB + 3 * 64);
    ATT_SB();
#pragma unroll
    for (int s = 0; s < 4; ++s) o[3] = __builtin_amdgcn_mfma_f32_32x32x16_bf16(vd[s], pf[s], o[3], 0, 0, 0);
    ATT_SB();
}

__device__ __forceinline__ void diff_unit(const Params& p, int l, LAS unsigned char* lds, int b, int h, int qrow0, int NT) {
    const int tid = fresh_tid(), lane = tid & 63, w = __builtin_amdgcn_readfirstlane(tid >> 6), r32 = lane & 31, hi = lane >> 5;
    const int map = w >> 2, qs = w & 3;
    const bf16_t* Z1 = (const bf16_t*)(p.ws + WS_Z1);
    const int qrow = qrow0 + qs * 32 + r32;
    {
        u32x4 qv[4];
#pragma unroll
        for (int i = 0; i < 4; ++i) { const int c = tid + 512 * i, row = c >> 4, ch = c & 15; qv[i] = *(const u32x4*)(Z1 + (size_t)(qrow0 + row) * ZC + h * 128 + ch * 8); }
#pragma unroll
        for (int i = 0; i < 4; ++i) { const int c = tid + 512 * i, row = c >> 4, ch = c & 15; *(LAS u32x4*)(lds + OFF3_Q + row * KPB + ch * 16) = qv[i]; }
    }
    LAS const unsigned char* Qt = lds + OFF3_Q + (qs * 32) * KPB + map * 128;
    const bf16_t* KVb = (const bf16_t*)(p.ws + WS_KVD) + (size_t)(b * 4 + h) * KVT * KVROW;
    const int vlane = (4 * hi + ((lane & 15) >> 2)) * VPB + ((lane >> 4) & 1) * 32 + (lane & 3) * 8;
    f32x16 o[4];
#pragma unroll
    for (int d0 = 0; d0 < 4; ++d0)
#pragma unroll
        for (int r = 0; r < 16; ++r) o[d0][r] = 0.f;
    float m = -1e30f, lsum = 0.f;
    TileRegs R;
#define DIFF_TROW(j) ((j) * 64)
    tile_load(R, KVb, DIFF_TROW(0), tid);
    tile_store(R, lds + OFF3_K, lds + OFF3_V, tid);
    if (1 < NT) { tile_load(R, KVb, DIFF_TROW(1), tid); tile_store(R, lds + OFF3_K + KBUF, lds + OFF3_V + VBUF, tid); }
    if (2 < NT) tile_load(R, KVb, DIFF_TROW(2), tid);
    __syncthreads();
    f32x16 sa0, sa1, sb0, sb1;
    st_qk(lds + OFF3_K + map * 128, Qt, sa0, sa1, r32, hi);
    int bj = 0;
#define DIFF_STEP(jj, SC0, SC1, SN0, SN1) do { \
        const int b1 = (bj == 2) ? 0 : bj + 1, b2 = (b1 == 2) ? 0 : b1 + 1; \
          \
        tile_store(R, lds + OFF3_K + b2 * KBUF, lds + OFF3_V + b2 * VBUF, tid); \
        tile_load(R, KVb, DIFF_TROW(min((jj) + 3, NT - 1)), tid); \
        st_qk(lds + OFF3_K + b1 * KBUF + map * 128, Qt, SN0, SN1, r32, hi); \
        LAS const unsigned char* Vt_ = lds + OFF3_V + bj * VBUF; \
        bf16x8 pf_[4]; \
        st_softmax(SC0, SC1, o, lsum, m, pf_); \
        ATT_SB(); \
        bf16x8 va_[4]; \
        _Pragma("unroll") for (int s_ = 0; s_ < 4; ++s_) va_[s_] = vfrag(Vt_ + vlane + s_ * 16 * VPB); \
        st_pv(Vt_, va_, pf_, o, vlane); \
        ATT_BAR(); \
        bj = b1; \
    } while (0)
    for (int j = 0; j < NT; j += 2) {
        DIFF_STEP(j, sa0, sa1, sb0, sb1);
        if (j + 1 < NT) DIFF_STEP(j + 1, sb0, sb1, sa0, sa1);
    }
#undef DIFF_STEP
    __syncthreads();
#undef DIFF_TROW
    int l_ = l; asm volatile("" : "+s"(l_));
    const float lam_init = l_ == 0 ? 0.200000000f : l_ == 1 ? 0.355509068f : l_ == 2 ? 0.470713018f : 0.556058204f;
    float lam;
    { const float a_ = p.lq1[l * 64 + lane] * p.lk1[l * 64 + lane], b_ = p.lq2[l * 64 + lane] * p.lk2[l * 64 + lane];
      lam = __expf(wave_sum(a_)) - __expf(wave_sum(b_)) + lam_init; }
    const float inv = 1.0f / (lsum + __shfl_xor(lsum, 32));
    LAS float* X = (LAS float*)lds;
    if (map == 1) {
        const float f = -lam * inv;
#pragma unroll
        for (int d0 = 0; d0 < 4; ++d0)
#pragma unroll
            for (int r = 0; r < 16; ++r) X[((qs * 4 + d0) * 16 + r) * 64 + lane] = o[d0][r] * f;
    }
    __syncthreads();
    if (map == 0) {
        f32x4 gq_[16];
        { const float* gs0 = p.g_subln + l * 128;
#pragma unroll
          for (int k = 0; k < 16; ++k) gq_[k] = *(const f32x4*)(gs0 + 32 * (k >> 2) + 8 * (k & 3) + 4 * hi); }
        __builtin_amdgcn_sched_barrier(0);
        float ss = 0.f;
#pragma unroll
        for (int d0 = 0; d0 < 4; ++d0)
#pragma unroll
            for (int r = 0; r < 16; ++r) { const float v = o[d0][r] * inv + X[((qs * 4 + d0) * 16 + r) * 64 + lane]; o[d0][r] = v; ss += v * v; }
        ss += __shfl_xor(ss, 32);
        const float rstd = rsqrtf(ss * (1.0f / 128.0f) + 1e-6f) * (1.0f - lam_init);
        bf16_t* orow = (bf16_t*)(p.ws + WS_A3) + (size_t)qrow * 512 + h * 128;
        const float* gs = p.g_subln + l * 128;
#pragma unroll
        for (int d0 = 0; d0 < 4; ++d0)
#pragma unroll
            for (int a = 0; a < 4; ++a) {
                const int dv = 32 * d0 + 8 * a + 4 * hi;
                const f32x4 g = gq_[d0 * 4 + a];
                u32x2 wv; wv.x = cvtpk(o[d0][4 * a] * rstd * g[0], o[d0][4 * a + 1] * rstd * g[1]); wv.y = cvtpk(o[d0][4 * a + 2] * rstd * g[2], o[d0][4 * a + 3] * rstd * g[3]);
                *(u32x2*)(orow + dv) = wv;
            }
    }
    __syncthreads();
}

__device__ __forceinline__ void nat_unit(const Params& p, int l, LAS unsigned char* lds, int b, int hp, int mode, int idx) {
    const int tid = fresh_tid(), lane = tid & 63, w = __builtin_amdgcn_readfirstlane(tid >> 6), r32 = lane & 31, hi = lane >> 5;
    const int hsel = w & 1, head = 2 * hp + hsel;
    const bf16_t* Z1 = (const bf16_t*)(p.ws + WS_Z1);
    int qrow, qc = 0, cs = 0, grow = 0, s0r = 0, sr = 0, NT = 4;
    if (mode == 0) {
        const int rsel = (w >> 1) & 1, csel = w >> 2;
        grow = 2 * idx + rsel; qc = csel * 32 + r32; cs = min(max(qc - 8, 0), 48);
        qrow = b * 2048 + grow * 64 + qc;
        s0r = min(max(2 * idx - 4, 0), 24); const int s1r = min(max(2 * idx + 1 - 4, 0), 24);
        sr = rsel ? s1r : s0r; NT = 4 + (s1r + 8 - s0r);
    } else {
        const int qs = w >> 1;
        qrow = ML + b * 256 + idx * 128 + qs * 32 + r32;
    }
    bf16x8 qf[4];
#pragma unroll
    for (int ks = 0; ks < 4; ++ks) qf[ks] = *(const bf16x8*)(Z1 + (size_t)qrow * ZC + 1024 + head * 64 + ks * 16 + hi * 8);
    const bf16_t* KVb = (const bf16_t*)(p.ws + WS_KVN) + (size_t)(b * 4 + hp) * KVT * KVROW;
    const int vlane = (4 * hi + ((lane & 15) >> 2)) * VPB + ((lane >> 4) & 1) * 32 + (lane & 3) * 8;
    LAS float* rpbL = (LAS float*)(lds + OFF_RPB);
    { const float* src = p.nat_rpb + (size_t)(l * 8 + 2 * hp) * 465; for (int i = tid; i < 930; i += 512) rpbL[i] = src[i]; }
    f32x16 o[2];
#pragma unroll
    for (int d0 = 0; d0 < 2; ++d0)
#pragma unroll
        for (int r = 0; r < 16; ++r) o[d0][r] = 0.f;
    float m = -1e30f; f32x16 lacc;
#pragma unroll
    for (int r = 0; r < 16; ++r) lacc[r] = 0.f;
    TileRegs R;
#define NAT_TROW(j) ((j) < 4 ? (j) * 64 : 256 + (s0r + (j) - 4) * 64)
    TileRegs Rb;
    tile_load(R, KVb, NAT_TROW(0), tid);
    tile_store(R, lds + OFF_K, lds + OFF_V, tid);
    if (1 < NT) tile_load(R, KVb, NAT_TROW(1), tid);
    if (2 < NT) tile_load(Rb, KVb, NAT_TROW(2), tid);
    __syncthreads();
    bf16x8 pf[4];
#define NAT_STEP(jj, KB, VB) do { \
        LAS const unsigned char* Kt = lds + OFF_K + (KB) + hsel * 128; LAS const unsigned char* Vt = lds + OFF_V + (VB) + hsel * 128; \
        const int kr = s0r + (jj) - 4; \
        if ((jj) < 4) { attn_qks<2, 0>(Kt, qf, o, lacc, m, pf, r32, hi, nullptr, 0, 0); attn_pv<2>(Vt, pf, o, lacc, vlane); } \
        else if (kr >= sr && kr < sr + 8) { attn_qks<2, 1>(Kt, qf, o, lacc, m, pf, r32, hi, rpbL + (hsel * 15 + (kr - grow + 7)) * 31, qc, cs); attn_pv<2>(Vt, pf, o, lacc, vlane); } \
    } while (0)
    for (int j = 0; j < NT; j += 2) {
        NAT_STEP(j, 0, 0);
        if (j + 1 < NT) tile_store(R, lds + OFF_K + KBUF, lds + OFF_V + VBUF, tid);
        if (j + 3 < NT) tile_load(R, KVb, NAT_TROW(j + 3), tid);
        ATT_BAR();
        if (j + 1 < NT) {
            NAT_STEP(j + 1, KBUF, VBUF);
            if (j + 2 < NT) tile_store(Rb, lds + OFF_K, lds + OFF_V, tid);
            if (j + 4 < NT) tile_load(Rb, KVb, NAT_TROW(j + 4), tid);
            ATT_BAR();
        }
    }
#undef NAT_STEP
    __syncthreads();
#undef NAT_TROW
    const float inv = 1.0f / lacc[0];
    bf16_t* orow = (bf16_t*)(p.ws + WS_A3) + (size_t)2 * MT * 512 + (size_t)qrow * 512 + head * 64;
#pragma unroll
    for (int d0 = 0; d0 < 2; ++d0)
#pragma unroll
        for (int a = 0; a < 4; ++a) {
            const int dv = 32 * d0 + 8 * a + 4 * hi;
            u32x2 wv; wv.x = cvtpk(o[d0][4 * a] * inv, o[d0][4 * a + 1] * inv); wv.y = cvtpk(o[d0][4 * a + 2] * inv, o[d0][4 * a + 3] * inv);
            *(u32x2*)(orow + dv) = wv;
        }
}
}

__device__ __forceinline__ void pool_unit(const Params& p, int unit) {
    const int tid = fresh_tid(), lane = tid & 63, w = tid >> 6;
    const bf16_t* Z1 = (const bf16_t*)(p.ws + WS_Z1);
    bf16_t* P = (bf16_t*)(p.ws + WS_A3) + (size_t)MT * 512;
    const int half = 1 << (lane >> 4);
#pragma unroll 2
    for (int i = 0; i < 8; ++i) {
        const int row = unit * 64 + w * 8 + i;
        int sb, t, L;
        if (row < ML) { sb = row & ~2047; t = row & 2047; L = 2048; } else { sb = ML + ((row - ML) & ~255); t = (row - ML) & 255; L = 256; }
        const int lo = max(t - half, 0), hi = min(t + half, L);
        float acc[8];
#pragma unroll
        for (int e = 0; e < 8; ++e) acc[e] = 0.f;
        const bf16_t* base = Z1 + (size_t)sb * ZC + 512 + lane * 8;
        u32x4 wv[16];
#pragma unroll
        for (int k = 0; k < 16; ++k) { const int s_ = lo + k; wv[k] = *(const u32x4*)(base + (size_t)(s_ < hi ? s_ : lo) * ZC); }
        const u32x4 sv = *(const u32x4*)(base + (size_t)t * ZC);
        __builtin_amdgcn_sched_barrier(0);
#pragma unroll
        for (int k = 0; k < 16; ++k) {
            const float f_ = (lo + k < hi) ? 1.0f : 0.0f; const u32x4 v = wv[k];
            acc[0] += f_ * __uint_as_float(v.x << 16); acc[1] += f_ * __uint_as_float(v.x & 0xffff0000u);
            acc[2] += f_ * __uint_as_float(v.y << 16); acc[3] += f_ * __uint_as_float(v.y & 0xffff0000u);
            acc[4] += f_ * __uint_as_float(v.z << 16); acc[5] += f_ * __uint_as_float(v.z & 0xffff0000u);
            acc[6] += f_ * __uint_as_float(v.w << 16); acc[7] += f_ * __uint_as_float(v.w & 0xffff0000u);
        }
        const float ic = 1.0f / (float)(hi - lo);
        float uu[8] = {__uint_as_float(sv.x << 16), __uint_as_float(sv.x & 0xffff0000u), __uint_as_float(sv.y << 16), __uint_as_float(sv.y & 0xffff0000u),
                       __uint_as_float(sv.z << 16), __uint_as_float(sv.z & 0xffff0000u), __uint_as_float(sv.w << 16), __uint_as_float(sv.w & 0xffff0000u)};
        u32x4 ov; ov.x = cvtpk(acc[0] * ic - uu[0], acc[1] * ic - uu[1]); ov.y = cvtpk(acc[2] * ic - uu[2], acc[3] * ic - uu[3]);
        ov.z = cvtpk(acc[4] * ic - uu[4], acc[5] * ic - uu[5]); ov.w = cvtpk(acc[6] * ic - uu[6], acc[7] * ic - uu[7]);
        *(u32x4*)(P + (size_t)row * 512 + lane * 8) = ov;
    }
}

__device__ __forceinline__ void norm_rows(const Params& p, int l, int nrows, const float* gvec, int si, bool use_part, const float* srcL, const float* srcC) {
    const int tid = fresh_tid(), lane = tid & 63, w = tid >> 6;
    bf16_t* HN = (bf16_t*)(p.ws + WS_HN);
    const float* MOD = (const float*)(p.ws + WS_MOD) + (size_t)l * 9 * 6144;
    for (int row = blockIdx.x * 8 + w; row < nrows; row += gridDim.x * 8) {
        const float* xr = row < ML ? srcL + (size_t)row * DM : srcC + (size_t)(row - ML) * DM;
        const int b = row < ML ? (row >> 11) : 8;
        const float* sh = MOD + (size_t)b * 6144 + si * 1024; const float* sc = sh + 1024;
        f32x4 v[4], gq[4], s1q[4], s0q[4]; float ss = 0.f;
#pragma unroll
        for (int j = 0; j < 4; ++j) v[j] = ((const f32x4*)xr)[64 * j + lane];
#pragma unroll
        for (int j = 0; j < 4; ++j) { const int col = (64 * j + lane) * 4; gq[j] = *(const f32x4*)(gvec + col); s1q[j] = *(const f32x4*)(sc + col); s0q[j] = *(const f32x4*)(sh + col); }
        __builtin_amdgcn_sched_barrier(0);
        if (use_part && row >= ML) {
            const f32x4* pp = (const f32x4*)((const float*)(p.ws + WS_PART) + (size_t)(row - ML) * DM);
#pragma unroll
            for (int kh = 0; kh < 2; ++kh) {
                f32x4 pq[16];
#pragma unroll
                for (int k = 0; k < 4; ++k)
#pragma unroll
                    for (int j = 0; j < 4; ++j) pq[k * 4 + j] = pp[(size_t)(kh * 4 + k) * (MC * DM / 4) + 64 * j + lane];
                __builtin_amdgcn_sched_barrier(0);
#pragma unroll
                for (int k = 0; k < 4; ++k)
#pragma unroll
                    for (int j = 0; j < 4; ++j) v[j] += pq[k * 4 + j];
            }
#pragma unroll
            for (int j = 0; j < 4; ++j) ((f32x4*)xrow_ptr(p, row))[64 * j + lane] = v[j];
        }
#pragma unroll
        for (int j = 0; j < 4; ++j) ss += (v[j][0] * v[j][0] + v[j][1] * v[j][1]) + (v[j][2] * v[j][2] + v[j][3] * v[j][3]);
        const float rstd = rsqrtf(wave_sum(ss) * (1.0f / 1024.0f) + 1e-6f);
#pragma unroll
        for (int j = 0; j < 4; ++j) {
            const int col = (64 * j + lane) * 4;
            const f32x4 hv = v[j] * rstd * gq[j] * (s1q[j] + 1.0f) + s0q[j];
            u32x2 wv; wv.x = cvtpk(hv[0], hv[1]); wv.y = cvtpk(hv[2], hv[3]);
            *(u32x2*)(HN + (size_t)row * DM + col) = wv;
        }
    }
}
__device__ __forceinline__ void final_norm(const Params& p) {
    const int tid = fresh_tid(), lane = tid & 63, w = tid >> 6;
    for (int row = blockIdx.x * 8 + w; row < ML; row += gridDim.x * 8) {
        float* xr = p.out + (size_t)row * DM;
        f32x4 v[4], gq[4]; float ss = 0.f;
#pragma unroll
        for (int j = 0; j < 4; ++j) { v[j] = ((const f32x4*)xr)[64 * j + lane]; gq[j] = ((const f32x4*)p.g_final)[64 * j + lane]; }
        __builtin_amdgcn_sched_barrier(0);
#pragma unroll
        for (int j = 0; j < 4; ++j) ss += (v[j][0] * v[j][0] + v[j][1] * v[j][1]) + (v[j][2] * v[j][2] + v[j][3] * v[j][3]);
        const float rstd = rsqrtf(wave_sum(ss) * (1.0f / 1024.0f) + 1e-6f);
#pragma unroll
        for (int j = 0; j < 4; ++j) ((f32x4*)xr)[64 * j + lane] = v[j] * rstd * gq[j];
    }
}
__device__ __forceinline__ void cvt_item(const float* W, int K, int N, bf16_t* WT, int item, LAS float* scr, int lane, int nperm = 0) {
    const int nblk = N >> 5, kb = item / nblk, nb = item - kb * nblk, k0 = kb * 64, n0 = nb * 32;
    const int pl = lane & 31, srcn = (n0 < nperm) ? (16 * ((pl >> 2) & 1) + 4 * (pl >> 3) + (pl & 3)) : pl;
    float wq_[32];
#pragma unroll
    for (int i = 0; i < 32; ++i) wq_[i] = W[(size_t)(k0 + 2 * i + (lane >> 5)) * N + n0 + srcn];
    __builtin_amdgcn_sched_barrier(0);
#pragma unroll
    for (int i = 0; i < 32; ++i) scr[(2 * i + (lane >> 5)) * 33 + (lane & 31)] = wq_[i];
    asm volatile("s_waitcnt lgkmcnt(0)" ::: "memory");
    const int c = lane & 7;
#pragma unroll
    for (int j = 0; j < 4; ++j) { const int n = (lane >> 3) + 8 * j; LAS const float* sp = scr + (8 * c) * 33 + n;
        u32x4 o; o.x = cvtpk(sp[0], sp[33]); o.y = cvtpk(sp[2 * 33], sp[3 * 33]); o.z = cvtpk(sp[4 * 33], sp[5 * 33]); o.w = cvtpk(sp[6 * 33], sp[7 * 33]);
        *(u32x4*)(WT + (size_t)(n0 + n) * K + k0 + 8 * c) = o; }
    asm volatile("s_waitcnt lgkmcnt(0)" ::: "memory");
}
__device__ __forceinline__ void fold_unit(const Params& p, int l, int unit, LAS float* scr, size_t wo) {
    const int tid = fresh_tid(), g = unit >> 5, nt = (unit >> 1) & 15, ct = unit & 1;
    LAS float* As = scr; LAS float* Bs = scr + 64 * 129;
    const float* pw = p.pool_w + ((size_t)(l * 4 + g) * 128 + ct * 64) * 128;
    const float* ps = p.pool_scale + l * 512 + g * 128;
    const float* wb = p.w_branch + ((size_t)(l * 3 + 1) * 512 + g * 128) * 1024 + nt * 64;
    for (int i = tid; i < 64 * 128; i += 512) { const int c = i >> 7, e = i & 127; As[c * 129 + e] = pw[(size_t)c * 128 + e]; }
    for (int i = tid; i < 128 * 64; i += 512) { const int e = i >> 6, n = i & 63; Bs[e * 65 + n] = ps[e] * wb[(size_t)e * 1024 + n]; }
    __syncthreads();
    const int n = tid >> 3, cc = tid & 7;
    float acc[8];
#pragma unroll
    for (int j = 0; j < 8; ++j) acc[j] = 0.f;
    for (int e = 0; e < 128; ++e) {
        const float bv = Bs[e * 65 + n];
#pragma unroll
        for (int j = 0; j < 8; ++j) acc[j] += As[(cc * 8 + j) * 129 + e] * bv;
    }
    bf16_t* dst = (bf16_t*)(p.ws + wo + WS_WBR) + (size_t)(1024 + nt * 64 + n) * 512 + g * 128 + ct * 64 + cc * 8;
    u32x4 o; o.x = cvtpk(acc[0], acc[1]); o.y = cvtpk(acc[2], acc[3]); o.z = cvtpk(acc[4], acc[5]); o.w = cvtpk(acc[6], acc[7]);
    *(u32x4*)dst = o;
    __syncthreads();
}

__device__ __forceinline__ void adaln_units(const Params& p, LAS unsigned char* lds, int l0, int l1, int vb, int nb);
__device__ __forceinline__ void phase0(const Params& p, LAS unsigned char* lds) {
    const int tid = fresh_tid(), G = gridDim.x, bx = blockIdx.x;
    if (bx == 0 && tid < 16) {
        double inv = 1.0; for (int i = 0; i < tid; ++i) inv *= 0.5623413251903491;
        const double x2 = inv * inv; double term = inv, s = inv, c = 1.0, tc = 1.0;
        for (int k = 1; k <= 12; ++k) { term *= -x2 / (double)((2 * k) * (2 * k + 1)); s += term; tc *= -x2 / (double)((2 * k - 1) * (2 * k)); c += tc; }
        double cc = 1.0, sn = 0.0; float* T = (float*)(p.ws + WS_ROPE);
        for (int pos = 0; pos < 64; ++pos) { T[(pos * 16 + tid) * 2] = (float)cc; T[(pos * 16 + tid) * 2 + 1] = (float)sn; const double nc = cc * c - sn * s; sn = sn * c + cc * s; cc = nc; }
    }
    adaln_units(p, lds, 0, 1, bx, G);
}
__device__ __forceinline__ void adaln_units(const Params& p, LAS unsigned char* lds, int l0, int l1, int vb, int nb) {
    const int tid = fresh_tid();
    LAS float* sc = (LAS float*)lds; LAS float* red = sc + 9 * 1024;
    for (int i = tid; i < 9 * 1024; i += 512) { const int b = i >> 10, k = i & 1023; const float v = b < 8 ? p.c[b * 1024 + k] : p.c_ctx[k]; sc[i] = v / (1.0f + __expf(-v)); }
    __syncthreads();
    const int lane = tid & 63, w = tid >> 6;
    float* MOD = (float*)(p.ws + WS_MOD);
    for (int u = l0 * 96 + vb; u < l1 * 96; u += nb) {
        const int l = u / 96, n0 = (u - l * 96) * 64;
        float acc[9];
#pragma unroll
        for (int b = 0; b < 9; ++b) acc[b] = 0.f;
        const float* W = p.w_ada + (size_t)l * 1024 * 6144 + (size_t)(w * 128) * 6144 + n0 + lane;
#pragma unroll 1
        for (int k4 = 0; k4 < 128; k4 += 16) {
            float wq_[16];
#pragma unroll
            for (int i = 0; i < 16; ++i) wq_[i] = W[(size_t)(k4 + i) * 6144];
            __builtin_amdgcn_sched_barrier(0);
#pragma unroll
            for (int i = 0; i < 16; ++i) {
#pragma unroll
                for (int b = 0; b < 9; ++b) acc[b] += sc[b * 1024 + w * 128 + k4 + i] * wq_[i];
            }
        }
#pragma unroll
        for (int b = 0; b < 9; ++b) red[(w * 9 + b) * 64 + lane] = acc[b];
        __syncthreads();
        for (int i = tid; i < 576; i += 512) {
            const int b = i >> 6, ln = i & 63; float s = 0.f;
#pragma unroll
            for (int ww = 0; ww < 8; ++ww) s += red[(ww * 9 + b) * 64 + ln];
            MOD[(size_t)(l * 9 + b) * 6144 + n0 + ln] = s + p.b_ada[l * 6144 + n0 + ln];
        }
        __syncthreads();
    }
}

__device__ __forceinline__ void convert_weights(const Params& p, int l, LAS unsigned char* lds, int vb, int nb) {
    LAS float* scr = (LAS float*)lds;
    const size_t wo = (l & 1) ? WS_WSET1 : 0;
    {
        const int tid = fresh_tid(), lane = tid & 63, w = tid >> 6;
        LAS float* wscr = scr + w * (64 * 33);
        constexpr int T_IN = 16 * 208, T_BR = 8 * 32, T_OUT = 16 * 32, T_1 = 16 * 128, T_2 = 64 * 32, T_ALL = T_IN + 2 * T_BR + T_OUT + T_1 + T_2;
        for (int t = vb * 8 + w; t < T_ALL; t += nb * 8) {
            int r = t;
            if (r < T_IN) { cvt_item(p.w_in + (size_t)l * 1024 * INC, 1024, INC, (bf16_t*)(p.ws + wo + WS_WIN), r, wscr, lane, 1024); continue; } r -= T_IN;
            if (r < T_BR) { cvt_item(p.w_branch + (size_t)(l * 3 + 0) * 512 * 1024, 512, 1024, (bf16_t*)(p.ws + wo + WS_WBR), r, wscr, lane); continue; } r -= T_BR;
            if (r < T_BR) { cvt_item(p.w_branch + (size_t)(l * 3 + 2) * 512 * 1024, 512, 1024, (bf16_t*)(p.ws + wo + WS_WBR) + (size_t)2 * 1024 * 512, r, wscr, lane); continue; } r -= T_BR;
            if (r < T_OUT) { cvt_item(p.w_out + (size_t)l * 1024 * 1024, 1024, 1024, (bf16_t*)(p.ws + wo + WS_WOUT), r, wscr, lane); continue; } r -= T_OUT;
            if (r < T_1) { cvt_item(p.w_mlp1 + (size_t)l * 1024 * DFF, 1024, DFF, (bf16_t*)(p.ws + wo + WS_W1), r, wscr, lane); continue; } r -= T_1;
            cvt_item(p.w_mlp2 + (size_t)l * DFF * 1024, DFF, 1024, (bf16_t*)(p.ws + wo + WS_W2), r, wscr, lane);
        }
        __syncthreads();
    }
    for (int u = vb; u < 128; u += nb) fold_unit(p, l, u, scr, wo);
}
__device__ __forceinline__ void phaseA(const Params& p, int l, LAS unsigned char* lds) {
    if (l == 0) convert_weights(p, 0, lds, (int)blockIdx.x, (int)gridDim.x);
    norm_rows(p, l, MT, p.g_mix + l * 1024, 0, l > 0, l == 0 ? p.x : p.out, l == 0 ? p.ctx : (const float*)(p.ws + WS_XC));
}

__device__ __forceinline__ void phaseC(const Params& p, int l, LAS unsigned char* lds, int vb) {
    const int G = gridDim.x, lane = fresh_tid() & 63;
    const bool last = (l == DEPTH - 1);
    const int n_ctx = last ? 0 : 64;
    const int U1 = 512, U2 = 1024, U3 = U2 + n_ctx, U4 = U3 + n_ctx, U5 = U4 + (last ? ML : MT) / 64;
    for (int u = vb; u < U5; u += G) {
        if (u < U2) {
            const int uu = u & 511;
            const int vu = (G == 256) ? ((uu & 7) * 64 + (uu >> 8) * 32 + ((uu & 255) >> 3)) : uu;
            const int bh = vu >> 4, sub = vu & 15, b = bh >> 2, hq = bh & 3;
            if (u < U1) att::diff_unit(p, l, lds, b, hq, b * 2048 + sub * 128, 36);
            else att::nat_unit(p, l, lds, b, hq, 0, sub);
        } else if (u < U3) {
            const int v = u - U2, b = v >> 3, hq = (v >> 1) & 3, qb = v & 1;
            att::diff_unit(p, l, lds, b, hq, ML + b * 256 + qb * 128, 4);
        } else if (u < U4) {
            const int v = u - U3, b = v >> 3, hq = (v >> 1) & 3, qb = v & 1;
            att::nat_unit(p, l, lds, b, hq, 1, qb);
        } else {
            pool_unit(p, u - U4);
        }
    }
}

__global__ void __launch_bounds__(512, 2) fwd_megakernel(Params p) {
    extern __shared__ __attribute__((aligned(16))) unsigned char smem[];
    LAS unsigned char* lds = (LAS unsigned char*)smem;
    cg::grid_group grid = cg::this_grid();
    const int G = gridDim.x;
    volatile LAS unsigned* bst = (volatile LAS unsigned*)(lds + LDS_BYTES - 256);
    if (fresh_tid() < 2) bst[fresh_tid()] = 0u;
    __syncthreads();
    XcdBarrier bar = xcd_barrier_post((unsigned*)(p.ws + WS_CTL), bst);
    unsigned* cen = (unsigned*)(p.ws + WS_CTL) + 12288;
    if (fresh_tid() == 0) bst[2] = __hip_atomic_fetch_add(cen + bar.x * 16, 1u, __ATOMIC_RELAXED, __HIP_MEMORY_SCOPE_AGENT);
#ifndef ENABLE_MASK
#define ENABLE_MASK 0x3ff
#endif
#define PH_BEGIN(k) if (((ENABLE_MASK) >> (k)) & 1) {
#define PH_END   xcd_barrier(bar); }
#define PH_END0  if (p.ws == nullptr) grid.sync();        \
                 xcd_barrier(bar); }
#define PH_ENDL  }

    PH_BEGIN(0) phase0(p, lds); PH_END0
    if (fresh_tid() == 0) {
        bool even = (G % 8) == 0 && bar.x < 8u;
        for (int j = 0; j < 16; ++j) { const unsigned c_ = __hip_atomic_load(cen + j * 16, __ATOMIC_RELAXED, __HIP_MEMORY_SCOPE_AGENT); even = even && (c_ == (j < 8 ? (unsigned)(G / 8) : 0u)); }
        bst[3] = even ? bst[2] * 8u + bar.x : (unsigned)blockIdx.x;
    }
    __syncthreads();
    const int bx = __builtin_amdgcn_readfirstlane((int)bst[3]);

#pragma unroll 1
    for (int l = 0; l < DEPTH; ++l) {
        const bool last = (l == DEPTH - 1);
        const int Mx = last ? ML : MT;
        const float* MODl = (const float*)(p.ws + WS_MOD) + (size_t)l * 9 * 6144;
        const unsigned char* wsl = p.ws + ((l & 1) ? WS_WSET1 : 0);
        PH_BEGIN(1) phaseA(p, l, lds); PH_END
        PH_BEGIN(2) {
            pg8::Gemm g{(const bf16_t*)(p.ws + WS_HN), (const bf16_t*)(wsl + WS_WIN), MT, INC, DM}; InProjOrder S; S.init(G, bx, last ? 0 : 1);
            EpiInProj E{(bf16_t*)(p.ws + WS_Z1), (bf16_t*)(p.ws + WS_G), (const float*)(p.ws + WS_ROPE), (bf16_t*)(p.ws + WS_KVD), (bf16_t*)(p.ws + WS_KVN)};
            pg8::gemm_phase<EpiInProj, InProjOrder, true, true>(lds, g, S, E);
        } PH_END
        PH_BEGIN(3) phaseC(p, l, lds, bx); PH_END
        PH_BEGIN(4) {
            pg8::Gemm g{(const bf16_t*)(p.ws + WS_A3), (const bf16_t*)(wsl + WS_WBR), 3 * MT, 3 * 1024, 512}; BranchOrder S{last ? 0 : 32, G, bx};
            EpiBranch E{(const bf16_t*)(p.ws + WS_G), (bf16_t*)(p.ws + WS_MB)};
            pg8::gemm_phase<EpiBranch, BranchOrder, true, true>(lds, g, S, E);
            if (!last && G == 256) { if ((bx >> 3) >= 4) { adaln_units(p, lds, l + 1, l + 2, bx - 32, G - 32); __syncthreads(); convert_weights(p, l + 1, lds, bx - 32, G - 32); } }
            else if (!last) { adaln_units(p, lds, l + 1, l + 2, bx, G); __syncthreads(); convert_weights(p, l + 1, lds, bx, G); }
        } PH_END
        PH_BEGIN(5) {
            pg8::Gemm g{(const bf16_t*)(p.ws + WS_MB), (const bf16_t*)(wsl + WS_WOUT), Mx, DM, DM}; SplitOrder S; S.init(G, bx, DM, last ? 0 : 1);
            EpiResid E{l == 0 ? p.x : p.out, p.out, (float*)(p.ws + WS_PART), MODl, 2};
            pg8::gemm_phase<EpiResid, SplitOrder, true, true>(lds, g, S, E);
        } PH_END
        PH_BEGIN(6) norm_rows(p, l, Mx, p.g_mlp + l * 1024, 3, !last, p.out, l == 0 ? p.ctx : (const float*)(p.ws + WS_XC)); PH_END
        PH_BEGIN(7) {
            pg8::Gemm g{(const bf16_t*)(p.ws + WS_HN), (const bf16_t*)(wsl + WS_W1), Mx, DFF, DM}; pg8::StaticOrder S; S.init(Mx, DFF, G, bx, DM);
            EpiMlp1 E{(bf16_t*)(p.ws + WS_H)};
            pg8::gemm_phase<EpiMlp1, pg8::StaticOrder, true, true>(lds, g, S, E);
        } PH_END
        PH_BEGIN(8) {
            pg8::Gemm g{(const bf16_t*)(p.ws + WS_H), (const bf16_t*)(wsl + WS_W2), Mx, DM, DFF}; SplitOrder S; S.init(G, bx, DFF, last ? 0 : 1);
            EpiResid E{p.out, p.out, (float*)(p.ws + WS_PART), MODl, 5};
            pg8::gemm_phase<EpiResid, SplitOrder, true, true>(lds, g, S, E);
        } PH_END
    }
    PH_BEGIN(9) final_norm(p); PH_ENDL
#undef PH_BEGIN
#undef PH_END
#undef PH_END0
#undef PH_ENDL
}

#ifndef MK_MULTI
#define MK_MULTI 0
#endif
extern "C" void kernel_launch(void* const* d_in, const int* in_sizes, int n_in, void* d_out, int out_size, void* d_ws, size_t ws_size, hipStream_t stream) {
    static int grid_blocks = 0;
    if (grid_blocks == 0) {
        if (n_in != 22 || ws_size < WS_END) { fprintf(stderr, "kernel_launch: unexpected n_in %d / ws_size %zu (need %zu)\n", n_in, ws_size, (size_t)WS_END); grid_blocks = -1; return; }
        int dev = 0, cus = 0, per_cu = 0;
        hipGetDevice(&dev);
        hipDeviceGetAttribute(&cus, hipDeviceAttributeMultiprocessorCount, dev);
        if (hipFuncSetAttribute((const void*)fwd_megakernel, hipFuncAttributeMaxDynamicSharedMemorySize, LDS_BYTES) != hipSuccess) fprintf(stderr, "kernel_launch: hipFuncSetAttribute failed\n");
        hipOccupancyMaxActiveBlocksPerMultiprocessor(&per_cu, (const void*)fwd_megakernel, 512, LDS_BYTES);
        (void)hipGetLastError();
        if (per_cu < 1) { fprintf(stderr, "kernel_launch: occupancy query returned %d\n", per_cu); per_cu = 1; }
        grid_blocks = cus * per_cu;
    }
    if (grid_blocks < 0) return;
    if (hipMemsetAsync((char*)d_ws + WS_CTL, 0, 65536, stream) != hipSuccess) fprintf(stderr, "kernel_launch: memset failed\n");
    Params p{};
    const float** f = (const float**)&p;
    for (int i = 0; i < 22; ++i) f[i] = (const float*)d_in[i];
    p.out = (float*)d_out; p.ws = (unsigned char*)d_ws;
    void* args[] = {&p};
    hipError_t e = hipLaunchCooperativeKernel((const void*)fwd_megakernel, dim3(grid_blocks), dim3(512), args, LDS_BYTES, stream);
    if (e != hipSuccess) fprintf(stderr, "cooperative launch failed: %s (grid %d)\n", hipGetErrorString(e), grid_blocks);
}
```
